# Optimizing an MI355X kernel written in HIP

```python
import math
import jax, jax.numpy as jnp
from jax import lax
import numpy as np

D_MODEL = 4096
BATCH = 4
SEQ = 2048
DEPTH = 1

CHUNK = 64
D_MIX = D_MODEL
NORM_EPS = 1e-6
D_ATTN = D_MIX // 2
N_HEADS = 16
HEAD_DIM = D_ATTN // N_HEADS
KV_LATENT = 512
N_IDX_HEADS = 16
IDX_DIM = 64
TOPK_MAX = 256
Q_BLOCK = 128
D_POOL = D_MIX - D_ATTN
POOL_WINDOWS = (2, 4, 8, 16)
N_POOL_GROUPS = 4
POOL_GROUP = D_POOL // N_POOL_GROUPS
PROJ_SIZES = (D_ATTN, KV_LATENT, N_IDX_HEADS * IDX_DIM, IDX_DIM, N_IDX_HEADS, D_ATTN, D_POOL, D_POOL)
D_IN = sum(PROJ_SIZES)

kernel_name = "hybrid_dsa_pool_parallel_block"


def _rmsnorm(x, g):
    xf = x.astype(jnp.float32)
    y = xf * lax.rsqrt(jnp.mean(xf * xf, axis=-1, keepdims=True) + NORM_EPS)
    return (y * g.astype(jnp.float32)).astype(x.dtype)


def _layernorm(x, g, b):
    xf = x.astype(jnp.float32)
    mu = jnp.mean(xf, axis=-1, keepdims=True)
    var = jnp.mean(jnp.square(xf - mu), axis=-1, keepdims=True)
    y = (xf - mu) * lax.rsqrt(var + NORM_EPS)
    return (y * g.astype(jnp.float32) + b.astype(jnp.float32)).astype(x.dtype)


def _split_cols(z):
    offs = []
    acc = 0
    for s in PROJ_SIZES[:-1]:
        acc += s
        offs.append(acc)
    return jnp.split(z, offs, axis=-1)


def _dsa_attention(q, c, qi, k_idx, w_idx, k_top):
    B, S = q.shape[0], q.shape[1]
    nb = S // Q_BLOCK

    def blocks(a):
        a = a.reshape((B, nb, Q_BLOCK) + a.shape[2:])
        return jnp.moveaxis(a, 1, 0)

    key_chunk = jnp.arange(S) // CHUNK
    idx_scale = IDX_DIM ** -0.5
    attn_scale = HEAD_DIM ** -0.5

    def one_block(args):
        qb, qib, wb, t0 = args
        q_chunk = (t0 + jnp.arange(Q_BLOCK)) // CHUNK
        admissible = key_chunk[None, :] <= q_chunk[:, None]
        dots = jnp.einsum('bqhd,bsd->bqhs', qib.astype(jnp.float32), k_idx.astype(jnp.float32)) * idx_scale
        iscore = jnp.einsum('bqh,bqhs->bqs', wb.astype(jnp.float32), jax.nn.relu(dots))
        iscore = jnp.where(admissible[None], iscore, -jnp.inf)
        _, sel = lax.top_k(iscore, k_top)
        valid = (sel // CHUNK) <= q_chunk[None, :, None]
        c_sel = jax.vmap(lambda cb, ib: cb[ib])(c, sel)
        q_lat = jnp.einsum('bqhd,hcd->bqhc', qb, w_uk_g)
        scores = jnp.einsum('bqhc,bqkc->bqhk', q_lat, c_sel).astype(jnp.float32) * attn_scale
        scores = jnp.where(valid[:, :, None, :], scores, -jnp.inf)
        p = jax.nn.softmax(scores, axis=-1).astype(c.dtype)
        o_lat = jnp.einsum('bqhk,bqkc->bqhc', p, c_sel)
        return jnp.einsum('bqhc,hcd->bqhd', o_lat, w_uv_g)

    w_uk_g, w_uv_g = _dsa_attention.w_uk, _dsa_attention.w_uv
    out = lax.map(one_block, (blocks(q), blocks(qi), blocks(w_idx), jnp.arange(nb) * Q_BLOCK))
    return jnp.moveaxis(out, 0, 1).reshape(q.shape)


def _sparse_attention(q, c, qi, k_idx, w_idx, w_uk, w_uv, k_top):
    B, S = q.shape[0], q.shape[1]
    nb = S // Q_BLOCK

    def blocks(a):
        a = a.reshape((B, nb, Q_BLOCK) + a.shape[2:])
        return jnp.moveaxis(a, 1, 0)

    key_chunk = jnp.arange(S) // CHUNK
    idx_scale = IDX_DIM ** -0.5
    attn_scale = HEAD_DIM ** -0.5
    kf = k_idx.astype(jnp.float32)

    def one_block(args):
        qb, qib, wb, t0 = args
        q_chunk = (t0 + jnp.arange(Q_BLOCK)) // CHUNK
        admissible = key_chunk[None, :] <= q_chunk[:, None]
        dots = jnp.einsum('bqhd,bsd->bqhs', qib.astype(jnp.float32), kf) * idx_scale
        iscore = jnp.einsum('bqh,bqhs->bqs', wb.astype(jnp.float32), jax.nn.relu(dots))
        iscore = jnp.where(admissible[None], iscore, -jnp.inf)
        _, sel = lax.top_k(iscore, k_top)
        valid = (sel // CHUNK) <= q_chunk[None, :, None]
        c_sel = jax.vmap(lambda cb, ib: cb[ib])(c, sel)
        q_lat = jnp.einsum('bqhd,hcd->bqhc', qb, w_uk)
        scores = jnp.einsum('bqhc,bqkc->bqhk', q_lat, c_sel).astype(jnp.float32) * attn_scale
        scores = jnp.where(valid[:, :, None, :], scores, -jnp.inf)
        p = jax.nn.softmax(scores, axis=-1).astype(c_sel.dtype)
        o_lat = jnp.einsum('bqhk,bqkc->bqhc', p, c_sel)
        return jnp.einsum('bqhc,hcd->bqhd', o_lat, w_uv)

    out = lax.map(one_block, (blocks(q), blocks(qi), blocks(w_idx), jnp.arange(nb) * Q_BLOCK))
    return jnp.moveaxis(out, 0, 1).reshape(q.shape)


def _multiscale_pool(u, w_pool, pool_scale):
    B, S = u.shape[0], u.shape[1]
    p = u.reshape(B, S, N_POOL_GROUPS, POOL_GROUP).astype(jnp.float32)
    cs = jnp.concatenate([jnp.zeros((B, 1, N_POOL_GROUPS, POOL_GROUP), jnp.float32), jnp.cumsum(p, axis=1)], axis=1)
    pos = jnp.arange(S)
    win = jnp.array(POOL_WINDOWS, dtype=jnp.int32)
    start = jnp.maximum(pos[:, None] + 1 - win[None, :], 0)
    count = (pos[:, None] + 1 - start).astype(jnp.float32)
    gidx = jnp.broadcast_to(jnp.arange(N_POOL_GROUPS)[None, :], (S, N_POOL_GROUPS))
    cs_start = cs[:, start, gidx]
    mean = (cs[:, 1:] - cs_start) / count[None, :, :, None]
    mixed = (mean - p).astype(u.dtype)
    y = jnp.einsum('bsgc,gcd->bsgd', mixed, w_pool) * pool_scale.reshape(N_POOL_GROUPS, POOL_GROUP)
    return y.reshape(B, S, D_POOL)


def setup_inputs(seed: int = 0) -> dict:
    key = jax.random.key(seed)
    ks = jax.random.split(key, 14)
    f = jnp.float32
    x = jax.random.normal(ks[0], (BATCH, SEQ, D_MODEL), f)
    pre_norm = 1.0 + 0.02 * jax.random.normal(ks[1], (DEPTH, D_MODEL), f)
    w_in = jax.random.normal(ks[2], (DEPTH, D_MODEL, D_IN), f) * D_MODEL ** -0.5
    kv_norm = 1.0 + 0.02 * jax.random.normal(ks[3], (DEPTH, KV_LATENT), f)
    w_uk = jax.random.normal(ks[4], (DEPTH, N_HEADS, KV_LATENT, HEAD_DIM), f) * KV_LATENT ** -0.5
    w_uv = jax.random.normal(ks[5], (DEPTH, N_HEADS, KV_LATENT, HEAD_DIM), f) * KV_LATENT ** -0.5
    idx_k_norm_g = 1.0 + 0.02 * jax.random.normal(ks[6], (DEPTH, IDX_DIM), f)
    idx_k_norm_b = 0.02 * jax.random.normal(ks[7], (DEPTH, IDX_DIM), f)
    w_pool = jax.random.normal(ks[8], (DEPTH, N_POOL_GROUPS, POOL_GROUP, POOL_GROUP), f) * POOL_GROUP ** -0.5
    pool_scale = 1.0 + 0.02 * jax.random.normal(ks[9], (DEPTH, D_POOL), f)
    w_out = jax.random.normal(ks[10], (DEPTH, D_MIX, D_MODEL), f) * D_MIX ** -0.5
    post_norm = 1.0 + 0.02 * jax.random.normal(ks[11], (DEPTH, D_MODEL), f)
    return {"x": x, "pre_norm": pre_norm, "w_in": w_in, "kv_norm": kv_norm, "w_uk": w_uk, "w_uv": w_uv,
            "idx_k_norm_g": idx_k_norm_g, "idx_k_norm_b": idx_k_norm_b, "w_pool": w_pool,
            "pool_scale": pool_scale, "w_out": w_out, "post_norm": post_norm}


def reference(x, pre_norm, w_in, kv_norm, w_uk, w_uv, idx_k_norm_g, idx_k_norm_b, w_pool, pool_scale, w_out, post_norm):
    B, S, _ = x.shape
    k_top = min(TOPK_MAX, S // 4)
    for l in range(DEPTH):
        h = _rmsnorm(x, pre_norm[l])
        z = jnp.einsum('bsd,de->bse', h, w_in[l])
        q, c, qi, kix, wix, gate_a, pool_in, gate_b = _split_cols(z)
        q = q.reshape(B, S, N_HEADS, HEAD_DIM)
        c = _rmsnorm(c, kv_norm[l])
        qi = qi.reshape(B, S, N_IDX_HEADS, IDX_DIM)
        kix = _layernorm(kix, idx_k_norm_g[l], idx_k_norm_b[l])
        wix = wix * (N_IDX_HEADS ** -0.5)
        ya = _sparse_attention(q, c, qi, kix, wix, w_uk[l], w_uv[l], k_top).reshape(B, S, D_ATTN)
        ya = ya * jax.nn.silu(gate_a)
        yb = _multiscale_pool(pool_in, w_pool[l], pool_scale[l]) * jax.nn.silu(gate_b)
        y = jnp.einsum('bse,ed->bsd', jnp.concatenate([ya, yb], axis=-1), w_out[l])
        x = x + _rmsnorm(y, post_norm[l])
    return x
```

```cpp
#include <hip/hip_runtime.h>
#include <stdint.h>
#include <cstdio>

typedef unsigned short bf16_t;
typedef short bf16x8 __attribute__((ext_vector_type(8)));
typedef float f32x4 __attribute__((ext_vector_type(4)));

constexpr int T = 8192, S = 2048, DM = 4096, DIN = 9808;
constexpr int ZP = 9984;
constexpr int ZQ = 0, ZC = 2048, ZQI = 2560, ZKIX = 3584, ZWIX = 3648, ZGA = 3840, ZPI = 5888, ZGB = 7936;
constexpr float EPS = 1e-6f;

constexpr size_t MiB = 1u << 20;
constexpr size_t WS_CTL = 0;
constexpr size_t WS_WUK = 1 * MiB, WS_WUV2 = 3 * MiB, WS_WPOOL = 7 * MiB;
constexpr size_t WS_WOUT = 10 * MiB;
constexpr size_t WS_CN = 42 * MiB, WS_KIXN = 50 * MiB, WS_WIX = 51 * MiB, WS_ROWSS = 51 * MiB + 512 * 1024, WS_SEL = 52 * MiB;
constexpr size_t WS_XN = 56 * MiB;
constexpr size_t WS_WIN = 120 * MiB;
constexpr size_t WS_Z = 198 * MiB;
constexpr size_t WS_QL = 354 * MiB;
constexpr size_t WS_END = 482 * MiB;
constexpr size_t WS_XN8 = WS_QL, WS_W8 = WS_QL + 32 * MiB;
constexpr int NT8 = 18, NTB = 21;
__device__ __forceinline__ bool zcol_is_f8(int col) { return col < 2560 || (col >= ZGA && col < ZGA + 2048); }
constexpr size_t WS_Y = WS_WIN, WS_MIX = WS_WIN, WS_RSS = WS_WIN + 64 * MiB;

__device__ __forceinline__ bf16_t f2bf(float f) { unsigned u = __float_as_uint(f); u += 0x7fffu + ((u >> 16) & 1u); return (bf16_t)(u >> 16); }
__device__ __forceinline__ float bf2f(bf16_t b) { return __uint_as_float(((unsigned)b) << 16); }
__device__ __forceinline__ unsigned pk2(float lo, float hi) { return (unsigned)f2bf(lo) | ((unsigned)f2bf(hi) << 16); }
__device__ __forceinline__ float bflo(unsigned u) { return __uint_as_float(u << 16); }
__device__ __forceinline__ float bfhi(unsigned u) { return __uint_as_float(u & 0xffff0000u); }
__device__ __forceinline__ float wave_sum(float v) {
#pragma unroll
    for (int o = 1; o < 64; o <<= 1) v += __shfl_xor(v, o);
    return v;
}
__device__ __forceinline__ float wave_max(float v) {
#pragma unroll
    for (int o = 1; o < 64; o <<= 1) v = fmaxf(v, __shfl_xor(v, o));
    return v;
}
__device__ __forceinline__ float silu(float x) { return x / (1.f + __expf(-x)); }

#include <hip/hip_cooperative_groups.h>
namespace cg = cooperative_groups;
#define LAS __attribute__((address_space(3)))
#define GAS __attribute__((address_space(1)))
typedef unsigned u32x4 __attribute__((ext_vector_type(4)));
typedef unsigned u32x2 __attribute__((ext_vector_type(2)));
constexpr int NWAVES = 8;
constexpr int LDS_BYTES = 147456;

__device__ __forceinline__ int lane_id() { int l; asm volatile("v_mbcnt_lo_u32_b32 %0, -1, 0\n\tv_mbcnt_hi_u32_b32 %0, -1, %0" : "=v"(l)); return l; }
namespace pg8 {
constexpr int BM = 256, BK = 64, HALF = 128, HTB = HALF * BK * 2, STAGE_BYTES = 8 * HTB, NXCD = 8, WGM = 8;
__device__ __forceinline__ int lds_byte(int r, int c) { const int st = (r >> 4) * 2 + (c >> 5), rr = r & 15, cc = c & 31, ob = rr * 64 + cc * 2; return st * 1024 + (ob ^ (((ob >> 9) & 1) << 5)); }
__device__ __forceinline__ void stage_rc(int b, int& R, int& C) { const int st = b / 1024, sb = b % 1024, swz = sb ^ (((sb >> 9) & 1) << 5); R = (st >> 1) * 16 + swz / 64; C = (st & 1) * 32 + (swz % 64) / 2; }
__device__ __forceinline__ int perm32(int rho) { const int n = rho >> 4, i = rho & 15; return 8 * (i >> 2) + 4 * n + (i & 3); }
struct Unit { int pm, pn; };
typedef int v4i_t __attribute__((ext_vector_type(4)));
typedef int v8i_t __attribute__((ext_vector_type(8)));
struct Gemm { const bf16_t* A; const bf16_t* Bt; int lda, ldb, K, a_shift, a_mul; int nt8; float rs8; };
struct StaticOrder {
    int nM, nN, nwg, G, c;
    int p0, rs, ra;
    int nfb, nl, kl;
    __device__ void init(int M, int N, int G_, int c_) { nM = M / BM; nN = N / BM; nwg = nM * nN; G = G_; c = c_; p0 = 0; rs = 1 << 30; ra = 0; nfb = -1; nl = 0; kl = 0; }
    __device__ bool next(int i, Unit& u) const {
        long L;
        if (nfb < 0) L = (long)i * G + c;
        else if (c >= nfb) { if (i >= kl) return false; L = (long)(c - nfb) + (long)nl * i; }
        else L = (long)kl * nl + c + (long)nfb * i;
        if (L >= nwg) return false;
        int wgid = (int)L; { const int q = nwg / NXCD, r = nwg % NXCD, xcd = wgid % NXCD, off = wgid / NXCD; wgid = (xcd < r ? xcd * (q + 1) : r * (q + 1) + (xcd - r) * q) + off; }
        const int nig = WGM * nN, gid = wgid / nig, fm = gid * WGM, gsz = (nM - fm) < WGM ? (nM - fm) : WGM;
        u.pm = fm + ((wgid % nig) % gsz); const int pn = (wgid % nig) / gsz; u.pn = p0 + pn + (pn >= rs ? ra : 0); return true;
    }
};
__device__ __forceinline__ unsigned cvt_pk_bf16(float lo, float hi) { unsigned r; asm volatile("v_cvt_pk_bf16_f32 %0, %1, %2" : "=v"(r) : "v"(lo), "v"(hi)); return r; }

struct EpiStore {
    static constexpr bool FINAL = false;
    bf16_t* O; int ldc; float sc;
    __device__ __forceinline__ void operator()(const f32x4 (&acc)[2][2][4][2], const Unit& u, int wr, int wc, int fr, int fq) const {
        const int row0 = u.pm * BM + wr * 64 + fr, col0 = u.pn * BM + wc * 32 + 8 * fq;
#pragma unroll
        for (int ai = 0; ai < 2; ++ai)
#pragma unroll
            for (int m = 0; m < 4; ++m) { bf16_t* rowp = O + (size_t)(row0 + ai * HALF + m * 16) * ldc + col0;
#pragma unroll
                for (int bj = 0; bj < 2; ++bj) { const f32x4 v0 = acc[ai][bj][m][0] * sc, v1 = acc[ai][bj][m][1] * sc;
                    u32x4 w; w.x = cvt_pk_bf16(v0[0], v0[1]); w.y = cvt_pk_bf16(v0[2], v0[3]); w.z = cvt_pk_bf16(v1[0], v1[1]); w.w = cvt_pk_bf16(v1[2], v1[3]);
                    *(u32x4*)(rowp + bj * HALF) = w; } }
    }
};

__device__ __forceinline__ float fsilu(float x) { return x * __builtin_amdgcn_rcpf(1.f + __expf(-x)); }
struct EpiGate {
    static constexpr bool FINAL = false;
    bf16_t* O; int ldc, ocol; const bf16_t* Zg; int gcol; const float* scale;
    __device__ __forceinline__ void operator()(const f32x4 (&acc)[2][2][4][2], const Unit& u, int wr, int wc, int fr, int fq) const {
        const int row0 = u.pm * BM + wr * 64 + fr, c0 = u.pn * BM + wc * 32 + 8 * fq;
#pragma unroll
        for (int ai = 0; ai < 2; ++ai)
#pragma unroll
            for (int m = 0; m < 4; ++m) { const size_t row = (size_t)(row0 + ai * HALF + m * 16);
#pragma unroll
                for (int bj = 0; bj < 2; ++bj) { const int c = c0 + bj * HALF;
                    const uint4 gz = *(const uint4*)(Zg + row * ZP + gcol + c);
                    f32x4 v0 = acc[ai][bj][m][0], v1 = acc[ai][bj][m][1];
                    if (scale) { v0 = v0 * *(const f32x4*)(scale + c); v1 = v1 * *(const f32x4*)(scale + c + 4); }
                    u32x4 w; w.x = cvt_pk_bf16(v0[0] * fsilu(bflo(gz.x)), v0[1] * fsilu(bfhi(gz.x))); w.y = cvt_pk_bf16(v0[2] * fsilu(bflo(gz.y)), v0[3] * fsilu(bfhi(gz.y)));
                    w.z = cvt_pk_bf16(v1[0] * fsilu(bflo(gz.z)), v1[1] * fsilu(bfhi(gz.z))); w.w = cvt_pk_bf16(v1[2] * fsilu(bflo(gz.w)), v1[3] * fsilu(bfhi(gz.w)));
                    *(u32x4*)(O + row * ldc + ocol + c) = w; } }
    }
};
struct EpiGate8 {
    static constexpr bool FINAL = false;
    unsigned char* O8; int pitch; const bf16_t* Zg; int gcol; float mul;
    __device__ __forceinline__ void operator()(const f32x4 (&acc)[2][2][4][2], const Unit& u, int wr, int wc, int fr, int fq) const {
        const int row0 = u.pm * BM + wr * 64 + fr, c0 = u.pn * BM + wc * 32 + 8 * fq;
#pragma unroll
        for (int ai = 0; ai < 2; ++ai)
#pragma unroll
            for (int m = 0; m < 4; ++m) { const size_t row = (size_t)(row0 + ai * HALF + m * 16);
#pragma unroll
                for (int bj = 0; bj < 2; ++bj) { const int c = c0 + bj * HALF;
                    const uint4 gz = *(const uint4*)(Zg + row * ZP + gcol + c);
                    const f32x4 v0 = acc[ai][bj][m][0] * mul, v1 = acc[ai][bj][m][1] * mul;
                    int lo = 0, hi = 0;
                    lo = __builtin_amdgcn_cvt_pk_fp8_f32(v0[0] * fsilu(bflo(gz.x)), v0[1] * fsilu(bfhi(gz.x)), lo, false); lo = __builtin_amdgcn_cvt_pk_fp8_f32(v0[2] * fsilu(bflo(gz.y)), v0[3] * fsilu(bfhi(gz.y)), lo, true);
                    hi = __builtin_amdgcn_cvt_pk_fp8_f32(v1[0] * fsilu(bflo(gz.z)), v1[1] * fsilu(bfhi(gz.z)), hi, false); hi = __builtin_amdgcn_cvt_pk_fp8_f32(v1[2] * fsilu(bflo(gz.w)), v1[3] * fsilu(bfhi(gz.w)), hi, true);
                    u32x2 w; w.x = (unsigned)lo; w.y = (unsigned)hi;
                    *(u32x2*)(O8 + row * (size_t)pitch + c) = w; } }
    }
};
struct EpiOut {
    static constexpr bool FINAL = false;
    bf16_t* Y; float* RSS;
    __device__ __forceinline__ void operator()(const f32x4 (&acc)[2][2][4][2], const Unit& u, int wr, int wc, int fr, int fq) const {
        const int row0 = u.pm * BM + wr * 64 + fr, col0 = u.pn * BM + wc * 32 + 8 * fq;
#pragma unroll
        for (int ai = 0; ai < 2; ++ai)
#pragma unroll
            for (int m = 0; m < 4; ++m) { const size_t row = (size_t)(row0 + ai * HALF + m * 16); float ss = 0.f;
#pragma unroll
                for (int bj = 0; bj < 2; ++bj) { const f32x4 v0 = acc[ai][bj][m][0], v1 = acc[ai][bj][m][1];
                    ss += (v0[0] * v0[0] + v0[1] * v0[1]) + (v0[2] * v0[2] + v0[3] * v0[3]) + (v1[0] * v1[0] + v1[1] * v1[1]) + (v1[2] * v1[2] + v1[3] * v1[3]);
                    u32x4 w; w.x = cvt_pk_bf16(v0[0], v0[1]); w.y = cvt_pk_bf16(v0[2], v0[3]); w.z = cvt_pk_bf16(v1[0], v1[1]); w.w = cvt_pk_bf16(v1[2], v1[3]);
                    *(u32x4*)(Y + row * DM + col0 + bj * HALF) = w; }
                ss += __shfl_xor(ss, 16); ss += __shfl_xor(ss, 32);
                if (fq == 0) RSS[row * 64 + u.pn * 4 + wc] = ss; }
    }
};

struct EpiStore8 {
    unsigned char* O; size_t pitch;
    __device__ __forceinline__ void operator()(const f32x4 (&acc)[2][2][4][2], const Unit& u, int wr, int wc, int fr, int fq) const {
        const int row0 = u.pm * BM + wr * 64 + fr, col0 = u.pn * BM + wc * 32 + 8 * fq;
#pragma unroll
        for (int ai = 0; ai < 2; ++ai)
#pragma unroll
            for (int m = 0; m < 4; ++m) { unsigned char* rowp = O + (size_t)(row0 + ai * HALF + m * 16) * pitch + col0;
#pragma unroll
                for (int bj = 0; bj < 2; ++bj) { const f32x4 v0 = acc[ai][bj][m][0], v1 = acc[ai][bj][m][1];
                    int lo = 0, hi = 0;
                    lo = __builtin_amdgcn_cvt_pk_fp8_f32(v0[0], v0[1], lo, false); lo = __builtin_amdgcn_cvt_pk_fp8_f32(v0[2], v0[3], lo, true);
                    hi = __builtin_amdgcn_cvt_pk_fp8_f32(v1[0], v1[1], hi, false); hi = __builtin_amdgcn_cvt_pk_fp8_f32(v1[2], v1[3], hi, true);
                    u32x2 w; w.x = (unsigned)lo; w.y = (unsigned)hi;
                    *(u32x2*)(rowp + bj * HALF) = w; } }
    }
};

template <class Epi, bool ALIGN_EPI, bool SP2, int MODE = 0>
__device__ __forceinline__ void gemm_phase(LAS unsigned char* lds, const int wave_id, const Gemm g, const StaticOrder& S, const Epi& E) {
    int lane = lane_id(); asm volatile("" : "+v"(lane));
    const int wid = wave_id, tid = wid * 64 + lane, wr = wid >> 2, wc = wid & 3, fr = lane & 15, fq = lane >> 4;
    const int K = g.K, nt = K / BK;
    unsigned voffA[2], voffB[2];
#pragma unroll
    for (int i = 0; i < 2; ++i) { int R, C; stage_rc(tid * 16 + i * 8192, R, C); const int Rb = (R & ~31) + perm32(R & 31);
        voffA[i] = (unsigned)(R * g.lda + C) * 2u; voffB[i] = (unsigned)(Rb * g.ldb + C) * 2u; }
    const size_t kstep = (size_t)(BK * 2);
    const size_t hstepA = (size_t)HALF * g.lda * 2, hstepB = (size_t)HALF * g.ldb * 2;
    const size_t tstepA = 2 * hstepA, tstepB = 2 * hstepB;
    const unsigned ldsw = (unsigned)wid * 1024u;
    const int aoff = lds_byte(wr * 64 + fr, fq * 8), boff = lds_byte(wc * 32 + fr, fq * 8);
#define PG8_SA(b, h) (((b) * 2 + (h)) * HTB)
#define PG8_SB(b, h) ((4 + (b) * 2 + (h)) * HTB)
#define PG8_STAGE(bufoff, gbase, voff) do { _Pragma("unroll") for (int _i = 0; _i < 2; ++_i) \
        __builtin_amdgcn_global_load_lds((const unsigned*)((const char*)(gbase) + (voff)[_i]), (LAS unsigned*)(lds + (bufoff) + ldsw + _i * 8192), 16, 0, 0); } while (0)
#define PG8_CAT(x, y) __builtin_shufflevector((x), (y), 0, 1, 2, 3, 4, 5, 6, 7)
#define PG8_LDA(dst, b, h, F8) do { _Pragma("unroll") for (int m = 0; m < 4; ++m) { \
        if constexpr (F8) dst##8[m] = PG8_CAT(*(const LAS v4i_t*)(lds + PG8_SA(b, h) + aoff + m * 2048), *(const LAS v4i_t*)(lds + PG8_SA(b, h) + aoff + m * 2048 + 1024)); \
        else { _Pragma("unroll") for (int k = 0; k < 2; ++k) dst[m][k] = *(const LAS bf16x8*)(lds + PG8_SA(b, h) + aoff + m * 2048 + k * 1024); } } } while (0)
#define PG8_LDB(dst, b, h, F8) do { _Pragma("unroll") for (int n = 0; n < 2; ++n) { \
        if constexpr (F8) dst##8[n] = PG8_CAT(*(const LAS v4i_t*)(lds + PG8_SB(b, h) + boff + n * 2048), *(const LAS v4i_t*)(lds + PG8_SB(b, h) + boff + n * 2048 + 1024)); \
        else { _Pragma("unroll") for (int k = 0; k < 2; ++k) dst[n][k] = *(const LAS bf16x8*)(lds + PG8_SB(b, h) + boff + n * 2048 + k * 1024); } } } while (0)
#define PG8_MMA(ai, bj, At, Bt, F8) do { __builtin_amdgcn_s_setprio(1); _Pragma("unroll") for (int m = 0; m < 4; ++m) _Pragma("unroll") for (int n = 0; n < 2; ++n) { \
        if constexpr (F8) asm volatile("v_mfma_f32_16x16x128_f8f6f4 %0, %1, %2, %0" : "+v"(acc[ai][bj][m][n]) : "v"(Bt##8[n]), "v"(At##8[m])); \
        else { _Pragma("unroll") for (int k = 0; k < 2; ++k) acc[ai][bj][m][n] = __builtin_amdgcn_mfma_f32_16x16x32_bf16(Bt[n][k], At[m][k], acc[ai][bj][m][n], 0, 0, 0); } } \
        __builtin_amdgcn_s_setprio(0); } while (0)
#define PG8_WAIT_V(n) asm volatile("s_waitcnt vmcnt(" #n ")" ::: "memory")
#define PG8_WAIT_L(n) asm volatile("s_waitcnt lgkmcnt(" #n ")" ::: "memory")
#define PG8_BAR __builtin_amdgcn_s_barrier()
#define PG8_SCHED __builtin_amdgcn_sched_barrier(0)
#define PG8_ABASE(u) ((const char*)g.A + (size_t)(u).pm * tstepA + (size_t)(((u).pn >> g.a_shift) * g.a_mul) * 2)
#define PG8_BBASE(u) ((const char*)g.Bt + (size_t)(u).pn * tstepB)
    Unit cur, nxt; int ui = 0;
    if (!S.next(0, cur)) return;
    f32x4 acc[2][2][4][2];
#pragma unroll
    for (int a = 0; a < 2; ++a)
#pragma unroll
        for (int b = 0; b < 2; ++b)
#pragma unroll
            for (int m = 0; m < 4; ++m)
#pragma unroll
                for (int n = 0; n < 2; ++n) acc[a][b][m][n] = (f32x4){0.f, 0.f, 0.f, 0.f};
    bf16x8 At[4][2], B0[2][2], B1[2][2]; v8i_t At8[4], B08[2], B18[2];
    const char* cA = PG8_ABASE(cur); const char* cB = PG8_BBASE(cur);
    if constexpr (SP2) {
        PG8_STAGE(PG8_SB(0, 0), cB, voffB); PG8_STAGE(PG8_SB(0, 1), cB + hstepB, voffB); PG8_STAGE(PG8_SA(0, 0), cA, voffA); PG8_STAGE(PG8_SA(0, 1), cA + hstepA, voffA);
        if (wr == 1) PG8_BAR;
        PG8_WAIT_V(2); PG8_BAR;
        PG8_STAGE(PG8_SB(1, 0), cB + kstep, voffB); PG8_STAGE(PG8_SA(1, 0), cA + kstep, voffA); PG8_STAGE(PG8_SB(1, 1), cB + hstepB + kstep, voffB);
        PG8_WAIT_V(6); PG8_BAR;
    } else {
        PG8_STAGE(PG8_SB(0, 0), cB, voffB); PG8_STAGE(PG8_SA(0, 0), cA, voffA); PG8_STAGE(PG8_SB(0, 1), cB + hstepB, voffB); PG8_STAGE(PG8_SA(0, 1), cA + hstepA, voffA);
        if (wr == 1) PG8_BAR;
        PG8_WAIT_V(4); PG8_BAR;
        PG8_STAGE(PG8_SB(1, 0), cB + kstep, voffB); PG8_STAGE(PG8_SA(1, 0), cA + kstep, voffA); PG8_STAGE(PG8_SB(1, 1), cB + hstepB + kstep, voffB);
        PG8_WAIT_V(6); PG8_BAR;
    }
    for (;;) {
        const bool has_next = S.next(ui + 1, nxt);
        const char* nA = has_next ? PG8_ABASE(nxt) : cA; const char* nB = has_next ? PG8_BBASE(nxt) : cB;
#define PG8_KPTRS() const bool last = (t == nt - 2); const char* a1 = cA + (size_t)(t + 1) * kstep; \
            const char* a2 = last ? nA : cA + (size_t)(t + 2) * kstep; const char* b2 = last ? nB : cB + (size_t)(t + 2) * kstep; const char* a3 = a2 + kstep; const char* b3 = b2 + kstep
#define PG8_KBODY(F8) \
            PG8_LDB(B0, 0, 0, F8); PG8_LDB(B1, 0, 1, F8); PG8_SCHED; PG8_LDA(At, 0, 0, F8); PG8_STAGE(PG8_SA(1, 1), a1 + hstepA, voffA); \
            PG8_WAIT_V(8); PG8_WAIT_L(0); PG8_BAR; PG8_MMA(0, 0, At, B0, F8); PG8_MMA(0, 1, At, B1, F8); PG8_BAR; PG8_SCHED; \
            PG8_LDA(At, 0, 1, F8); PG8_STAGE(PG8_SB(0, 0), b2, voffB); PG8_STAGE(PG8_SB(0, 1), b2 + hstepB, voffB); PG8_STAGE(PG8_SA(0, 0), a2, voffA); \
            PG8_WAIT_V(8); PG8_WAIT_L(0); PG8_BAR; PG8_MMA(1, 0, At, B0, F8); PG8_MMA(1, 1, At, B1, F8); PG8_BAR; PG8_SCHED; \
            PG8_LDB(B0, 1, 0, F8); PG8_LDB(B1, 1, 1, F8); PG8_SCHED; PG8_LDA(At, 1, 0, F8); PG8_STAGE(PG8_SA(0, 1), a2 + hstepA, voffA); \
            PG8_WAIT_V(8); PG8_WAIT_L(0); PG8_BAR; PG8_MMA(0, 0, At, B0, F8); PG8_MMA(0, 1, At, B1, F8); PG8_BAR; PG8_SCHED; \
            PG8_LDA(At, 1, 1, F8); PG8_STAGE(PG8_SB(1, 0), b3, voffB); PG8_STAGE(PG8_SB(1, 1), b3 + hstepB, voffB); PG8_STAGE(PG8_SA(1, 0), a3, voffA); \
            PG8_WAIT_V(8); PG8_WAIT_L(0); PG8_BAR; PG8_MMA(1, 0, At, B0, F8); PG8_MMA(1, 1, At, B1, F8); PG8_BAR; PG8_SCHED
        int t = 0;
        if constexpr (MODE != 0) {
            const int nt8 = (MODE == 1) ? nt : g.nt8;
            for (; t < nt8; t += 2) { PG8_KPTRS(); PG8_KBODY(true); }
            if constexpr (MODE == 2) {
                asm volatile("s_nop 15\n\ts_nop 15" ::: "memory");
                const float rs8 = g.rs8;
#pragma unroll
                for (int a = 0; a < 2; ++a)
#pragma unroll
                    for (int b = 0; b < 2; ++b)
#pragma unroll
                        for (int m = 0; m < 4; ++m)
#pragma unroll
                            for (int n = 0; n < 2; ++n) acc[a][b][m][n] = acc[a][b][m][n] * rs8;
            }
        }
        if constexpr (MODE != 1) {
            for (; t < nt; t += 2) { PG8_KPTRS(); PG8_KBODY(false); }
        }
        if constexpr (ALIGN_EPI) { if (wr == 0) PG8_BAR; }
        if constexpr (MODE == 1) asm volatile("s_nop 15\n\ts_nop 15" ::: "memory");
        if constexpr (Epi::FINAL) { if (!has_next) E.final(acc, cur, wr, wc, fr, fq); else E(acc, cur, wr, wc, fr, fq); }
        else E(acc, cur, wr, wc, fr, fq);
        if (!has_next) break;
#pragma unroll
        for (int a = 0; a < 2; ++a)
#pragma unroll
            for (int b = 0; b < 2; ++b)
#pragma unroll
                for (int m = 0; m < 4; ++m)
#pragma unroll
                    for (int n = 0; n < 2; ++n) acc[a][b][m][n] = (f32x4){0.f, 0.f, 0.f, 0.f};
        cur = nxt; cA = nA; cB = nB; ++ui;
        if constexpr (ALIGN_EPI) { if (wr == 1) PG8_BAR; }
    }
    PG8_WAIT_V(0);
    if constexpr (!ALIGN_EPI) { if (wr == 0) PG8_BAR; }
    PG8_BAR;
#undef PG8_SA
#undef PG8_SB
#undef PG8_STAGE
#undef PG8_LDA
#undef PG8_LDB
#undef PG8_MMA
#undef PG8_KPTRS
#undef PG8_KBODY
#undef PG8_CAT
#undef PG8_WAIT_V
#undef PG8_WAIT_L
#undef PG8_BAR
#undef PG8_SCHED
#undef PG8_ABASE
#undef PG8_BBASE
}
}

__device__ __forceinline__ void relu_fmac(float& acc, float w, float d) { const float t = fmaxf(d, 0.f); asm("v_fmac_f32 %0, %1, %2" : "+v"(acc) : "v"(w), "v"(t)); }
__device__ __forceinline__ int count_ge8(unsigned u0, unsigned u1, unsigned u2, unsigned u3, unsigned u4, unsigned u5, unsigned u6, unsigned u7, unsigned c) {
    unsigned long long m0, m1, m2, m3, m4, m5, m6, m7;
    asm("v_cmp_ge_u32_e64 %0, %8, %16\n\tv_cmp_ge_u32_e64 %1, %9, %16\n\tv_cmp_ge_u32_e64 %2, %10, %16\n\tv_cmp_ge_u32_e64 %3, %11, %16\n\t"
        "v_cmp_ge_u32_e64 %4, %12, %16\n\tv_cmp_ge_u32_e64 %5, %13, %16\n\tv_cmp_ge_u32_e64 %6, %14, %16\n\tv_cmp_ge_u32_e64 %7, %15, %16"
        : "=&s"(m0), "=&s"(m1), "=&s"(m2), "=&s"(m3), "=&s"(m4), "=&s"(m5), "=&s"(m6), "=&s"(m7)
        : "v"(u0), "v"(u1), "v"(u2), "v"(u3), "v"(u4), "v"(u5), "v"(u6), "v"(u7), "v"(c));
    return (__builtin_popcountll(m0) + __builtin_popcountll(m1)) + (__builtin_popcountll(m2) + __builtin_popcountll(m3)) + ((__builtin_popcountll(m4) + __builtin_popcountll(m5)) + (__builtin_popcountll(m6) + __builtin_popcountll(m7)));
}
#define LDS_WAIT() asm volatile("s_waitcnt lgkmcnt(0)" ::: "memory")
struct P0Tile { const float* src; int ld; bf16_t* dst; int dld; };
__device__ __forceinline__ void p0_tile_load(const P0Tile& t, int lane, f32x4 (&v)[16]) {
#pragma unroll
    for (int i = 0; i < 16; ++i) v[i] = t.src ? __builtin_nontemporal_load((const f32x4*)(t.src + (size_t)((lane >> 4) + 4 * i) * t.ld + (lane & 15) * 4)) : (f32x4){0.f, 0.f, 0.f, 0.f};
}
__device__ __forceinline__ void p0_tile_store(const P0Tile& t, int lane, const f32x4 (&v)[16], LAS float* scr) {
#pragma unroll
    for (int i = 0; i < 16; ++i) { LAS float* p = scr + ((lane >> 4) + 4 * i) * 65 + (lane & 15) * 4; p[0] = v[i][0]; p[1] = v[i][1]; p[2] = v[i][2]; p[3] = v[i][3]; }
    LDS_WAIT(); asm volatile("" ::: "memory");
    const int c = lane >> 3, nl = lane & 7;
    if (t.dld < 0) {
#pragma unroll
        for (int j = 0; j < 8; ++j) { const LAS float* s = scr + (8 * c) * 65 + nl + 8 * j; int lo = 0, hi = 0;
            lo = __builtin_amdgcn_cvt_pk_fp8_f32(64.f * s[0 * 65], 64.f * s[1 * 65], lo, false); lo = __builtin_amdgcn_cvt_pk_fp8_f32(64.f * s[2 * 65], 64.f * s[3 * 65], lo, true);
            hi = __builtin_amdgcn_cvt_pk_fp8_f32(64.f * s[4 * 65], 64.f * s[5 * 65], hi, false); hi = __builtin_amdgcn_cvt_pk_fp8_f32(64.f * s[6 * 65], 64.f * s[7 * 65], hi, true);
            u32x2 o; o.x = (unsigned)lo; o.y = (unsigned)hi;
            *(u32x2*)((unsigned char*)t.dst + (size_t)(nl + 8 * j) * (size_t)(-t.dld) + 8 * c) = o; }
    } else
#pragma unroll
    for (int j = 0; j < 8; ++j) { const LAS float* s = scr + (8 * c) * 65 + nl + 8 * j;
        u32x4 o; o.x = pg8::cvt_pk_bf16(s[0 * 65], s[1 * 65]); o.y = pg8::cvt_pk_bf16(s[2 * 65], s[3 * 65]); o.z = pg8::cvt_pk_bf16(s[4 * 65], s[5 * 65]); o.w = pg8::cvt_pk_bf16(s[6 * 65], s[7 * 65]);
        *(u32x4*)(t.dst + (size_t)(nl + 8 * j) * t.dld + 8 * c) = o; }
    LDS_WAIT(); asm volatile("" ::: "memory");
}

#define XB_TMO      128
#define XB_XCNT(j)  (256  + 64 * (j))
#define XB_XSUB(j)  (1280 + 64 * (j))
#define XB_XGEN(j)  (2304 + 64 * (j))
#define XB_TOP      3328
#define XB_TOPGEN   3392
#define XCD_BAR_WORDS 3456
#define XB_SPIN_CAP (1u << 22)
__device__ __forceinline__ unsigned xb_ld(unsigned* p)              { return __hip_atomic_load(p, __ATOMIC_RELAXED, __HIP_MEMORY_SCOPE_AGENT); }
__device__ __forceinline__ unsigned xb_add(unsigned* p, unsigned v) { return __hip_atomic_fetch_add(p, v, __ATOMIC_RELAXED, __HIP_MEMORY_SCOPE_AGENT); }
__device__ __forceinline__ unsigned xb_xcc_id() { return (unsigned)__builtin_amdgcn_s_getreg((3 << 11) | 20) & 0xFu; }
#define XB_SPIN(cond, bar) do { unsigned _sp = 0; while (cond) { __builtin_amdgcn_s_sleep(1); \
    if ((++_sp & 255u) == 0u) { if (xb_ld(&(bar)[XB_TMO])) break; if (_sp > XB_SPIN_CAP) { atomicAdd(&(bar)[XB_TMO], 1u); break; } } } } while (0)
__device__ __forceinline__ void xcd_barrier_complete(unsigned* bar, unsigned x, unsigned G, unsigned& nloc, unsigned& nx) {
    unsigned sum, cnt, mine, sp = 0u;
    for (;;) {
        sum = 0u; cnt = 0u; mine = 0u;
#pragma unroll
        for (unsigned j = 0; j < 16; ++j) { const unsigned c = xb_ld(&bar[XB_XCNT(j)]); sum += c; cnt += (c > 0u) ? 1u : 0u; mine = (j == x) ? c : mine; }
        if (sum == G) break;
        __builtin_amdgcn_s_sleep(1);
        if ((++sp & 255u) == 0u) { if (xb_ld(&bar[XB_TMO])) break; if (sp > XB_SPIN_CAP) { atomicAdd(&bar[XB_TMO], 1u); break; } }
    }
    nloc = mine > 0u ? mine : 1u; nx = cnt > 0u ? cnt : 1u;
}
__device__ __forceinline__ void xcd_barrier(unsigned* bar, unsigned x, unsigned G, volatile LAS unsigned* st, bool is_leader) {
    asm volatile("s_waitcnt vmcnt(0)" ::: "memory");
    __syncthreads();
    if (is_leader) {
        __builtin_amdgcn_s_waitcnt(0);
        unsigned nloc = st[0], nx = st[1];
        if (nloc == 0u) { xcd_barrier_complete(bar, x, G, nloc, nx); st[0] = nloc; st[1] = nx; }
        const unsigned old = xb_add(&bar[XB_XSUB(x)], 1u);
        const unsigned gen = old / nloc;
        if (old + 1u == (gen + 1u) * nloc) {
            __builtin_amdgcn_fence(__ATOMIC_RELEASE, "agent");
            asm volatile("s_waitcnt vmcnt(0)" ::: "memory");
            const unsigned og = xb_add(&bar[XB_TOP], 1u);
            const unsigned tg = og / nx;
            if (og + 1u == (tg + 1u) * nx) xb_add(&bar[XB_TOPGEN], 1u);
            else XB_SPIN(xb_ld(&bar[XB_TOPGEN]) == tg, bar);
            __builtin_amdgcn_fence(__ATOMIC_ACQUIRE, "agent");
            xb_add(&bar[XB_XGEN(x)], 1u);
            asm volatile("s_waitcnt vmcnt(0)" ::: "memory");
        } else {
            XB_SPIN(xb_ld(&bar[XB_XGEN(x)]) == gen, bar);
            __builtin_amdgcn_fence(__ATOMIC_ACQUIRE, "agent");
            asm volatile("s_waitcnt vmcnt(0)" ::: "memory");
        }
    }
    __syncthreads();
}

struct EpiOutF {
    static constexpr bool FINAL = true;
    bf16_t* Y; float* RSS; const float* x; const float* pw; float* out; unsigned* bar; unsigned xcc, G; volatile LAS unsigned* st;
    __device__ __forceinline__ void operator()(const f32x4 (&acc)[2][2][4][2], const pg8::Unit& u, int wr, int wc, int fr, int fq) const { pg8::EpiOut E{Y, RSS}; E(acc, u, wr, wc, fr, fq); }
    __device__ __forceinline__ void final(const f32x4 (&acc)[2][2][4][2], const pg8::Unit& u, int wr, int wc, int fr, int fq) const {
        const int row0 = u.pm * pg8::BM + wr * 64 + fr, col0 = u.pn * pg8::BM + wc * 32 + 8 * fq;
#pragma unroll
        for (int ai = 0; ai < 2; ++ai)
#pragma unroll
            for (int m = 0; m < 4; ++m) { const size_t row = (size_t)(row0 + ai * pg8::HALF + m * 16); float ss = 0.f;
#pragma unroll
                for (int bj = 0; bj < 2; ++bj) { const f32x4 v0 = acc[ai][bj][m][0], v1 = acc[ai][bj][m][1];
                    ss += (v0[0] * v0[0] + v0[1] * v0[1]) + (v0[2] * v0[2] + v0[3] * v0[3]) + (v1[0] * v1[0] + v1[1] * v1[1]) + (v1[2] * v1[2] + v1[3] * v1[3]); }
                ss += __shfl_xor(ss, 16); ss += __shfl_xor(ss, 32);
                if (fq == 0) RSS[row * 64 + u.pn * 4 + wc] = ss; }
        xcd_barrier(bar, xcc, G, st, wr == 0 && wc == 0 && fr == 0 && fq == 0);
        f32x4 w0[2], w1[2];
#pragma unroll
        for (int bj = 0; bj < 2; ++bj) { w0[bj] = *(const f32x4*)(pw + col0 + bj * pg8::HALF); w1[bj] = *(const f32x4*)(pw + col0 + bj * pg8::HALF + 4); }
#pragma unroll
        for (int ai = 0; ai < 2; ++ai)
#pragma unroll
            for (int m = 0; m < 4; ++m) { const size_t row = (size_t)(row0 + ai * pg8::HALF + m * 16);
                const f32x4* rp = (const f32x4*)(RSS + row * 64 + 16 * fq);
                const f32x4 r0 = rp[0], r1 = rp[1], r2 = rp[2], r3 = rp[3];
                float ss = ((r0[0] + r0[1]) + (r0[2] + r0[3])) + ((r1[0] + r1[1]) + (r1[2] + r1[3])) + (((r2[0] + r2[1]) + (r2[2] + r2[3])) + ((r3[0] + r3[1]) + (r3[2] + r3[3])));
                ss += __shfl_xor(ss, 16); ss += __shfl_xor(ss, 32);
                const float rs = rsqrtf(ss * (1.f / DM) + EPS);
#pragma unroll
                for (int bj = 0; bj < 2; ++bj) { const size_t o = row * DM + col0 + bj * pg8::HALF;
                    const f32x4 x0 = __builtin_nontemporal_load((const f32x4*)(x + o)), x1 = __builtin_nontemporal_load((const f32x4*)(x + o + 4));
                    *(f32x4*)(out + o) = x0 + acc[ai][bj][m][0] * rs * w0[bj]; *(f32x4*)(out + o + 4) = x1 + acc[ai][bj][m][1] * rs * w1[bj]; } }
    }
};

#ifndef PROBE_DUP
#define PROBE_DUP 0
#endif
#define DUPN(k) (1 + (((PROBE_DUP) >> (k)) & 1))
struct MkArgs { const float* in[12]; float* out; unsigned char* ws; int ph_lo, ph_hi; };

__global__ void __launch_bounds__(NWAVES * 64, 2) mk_fwd(MkArgs a) {
    extern __shared__ __attribute__((aligned(1024))) unsigned char lds_raw[];
    cg::grid_group grid = cg::this_grid();
    LAS unsigned char* lds = (LAS unsigned char*)lds_raw;
    const int G = gridDim.x, bx = blockIdx.x;
    const int vcu = (G % 8 == 0) ? (bx % 8) * (G / 8) + bx / 8 : bx;
    const int NGW = G * NWAVES;
    const int wave0 = __builtin_amdgcn_readfirstlane((int)threadIdx.x >> 6);
#define PHASE_IDS() int lane = lane_id(); asm volatile("" : "+v"(lane)); const int wave = wave0, tid = wave * 64 + lane, gw = vcu * NWAVES + wave; (void)tid; (void)gw
    unsigned char* ws = a.ws;
    const float* x = a.in[0]; const float* pre_norm = a.in[1]; const float* w_in = a.in[2]; const float* kv_norm = a.in[3];
    const float* w_uk = a.in[4]; const float* w_uv = a.in[5]; const float* kg = a.in[6]; const float* kb = a.in[7];
    const float* w_pool = a.in[8]; const float* pool_scale = a.in[9]; const float* w_out = a.in[10]; const float* post_norm = a.in[11];
    bf16_t* XN = (bf16_t*)(ws + WS_XN); bf16_t* CAT = (bf16_t*)(ws + WS_XN); bf16_t* WIN = (bf16_t*)(ws + WS_WIN); bf16_t* Z = (bf16_t*)(ws + WS_Z);
    bf16_t* WOUT = (bf16_t*)(ws + WS_WOUT); bf16_t* WUK = (bf16_t*)(ws + WS_WUK); bf16_t* WUV2 = (bf16_t*)(ws + WS_WUV2); bf16_t* WPOOL = (bf16_t*)(ws + WS_WPOOL);
    bf16_t* CN = (bf16_t*)(ws + WS_CN); bf16_t* KIXN = (bf16_t*)(ws + WS_KIXN); float* WIX = (float*)(ws + WS_WIX);
    bf16_t* MIX = (bf16_t*)(ws + WS_MIX); bf16_t* Y = (bf16_t*)(ws + WS_Y); float* RSS = (float*)(ws + WS_RSS); bf16_t* QL = (bf16_t*)(ws + WS_QL);
    const int lo = a.ph_lo, hi = a.ph_hi;
#define IN(k) (lo <= (k) && (k) < hi)
    unsigned* const xbar = (unsigned*)(ws + WS_CTL) + 1024;
    volatile LAS unsigned* const xst = (volatile LAS unsigned*)(lds + 147456 - 64);
    if (a.ph_lo < 0) grid.sync();
    const unsigned xcc = xb_xcc_id();
    { const int _l = lane_id();
      if (wave0 == 0 && _l == 0) { xst[0] = 0u; xst[1] = 0u; (void)xb_add(&xbar[XB_XCNT(xcc)], 1u); } }
#define SEAM(k) do { if (IN(k) && IN((k) + 1)) { const int _l = lane_id(); xcd_barrier(xbar, xcc, (unsigned)G, xst, wave0 == 0 && _l == 0); } } while (0)

    constexpr int NB_IN = ZP / 64, I_IN = (DM / 64) * NB_IN;
    constexpr int I_OUT = (DM / 64) * (DM / 64);
    constexpr int I_POOL = 4 * 8 * 8;
    constexpr int I_UV = 16 * 8 * 2 * 2;
    constexpr int I_T = I_IN + I_OUT + I_POOL + I_UV;
    auto tile_of = [&](int it, int lane) -> P0Tile {
        P0Tile t;
        if (it < I_IN) { const int kb_ = it / NB_IN, nb = it % NB_IN; const int np = nb * 64 + (lane & 15) * 4;
            const int scol = np < 3664 ? np : (np >= 3840 ? np - 176 : -1);
            t.src = scol >= 0 ? w_in + (size_t)(kb_ * 64) * DIN + scol - (lane & 15) * 4 : nullptr; t.ld = DIN; t.dst = WIN + (size_t)(nb * 64) * DM + kb_ * 64; t.dld = DM;
            if (zcol_is_f8(nb * 64)) { t.dst = (bf16_t*)(ws + WS_W8 + (size_t)(nb * 64) * DM + kb_ * 64); t.dld = -DM; }
            return t; }
        it -= I_IN;
        if (it < I_OUT) { const int kb_ = it >> 6, nb = it & 63; t.src = w_out + (size_t)(kb_ * 64) * DM + nb * 64; t.ld = DM;
            if (kb_ < 32) { t.dst = (bf16_t*)(ws + WS_WOUT + (size_t)(nb * 64) * 6144 + kb_ * 64); t.dld = -6144; }
            else { t.dst = WOUT + (size_t)(nb * 64) * 3072 + 1024 + (kb_ - 32) * 64; t.dld = 3072; }
            return t; }
        it -= I_OUT;
        if (it < I_POOL) { const int g_ = it >> 6, kb_ = (it >> 3) & 7, nb = it & 7; t.src = w_pool + (size_t)g_ * 512 * 512 + (size_t)(kb_ * 64) * 512 + nb * 64; t.ld = 512;
            t.dst = WPOOL + (size_t)(g_ * 512 + nb * 64) * 512 + kb_ * 64; t.dld = 512; return t; }
        it -= I_POOL;
        { const int z = it & 1, r = it >> 1, h = r >> 4, kb_ = (r >> 1) & 7, nb = r & 1;
          t.src = z ? nullptr : w_uv + (size_t)h * 512 * 128 + (size_t)(kb_ * 64) * 128 + nb * 64; t.ld = 128;
          t.dst = (bf16_t*)((unsigned char*)WUV2 + (size_t)(h * 128 + nb * 64) * 1024 + ((h & 1) ^ z) * 512 + kb_ * 64); t.dld = -1024; return t; }
    };
#define P0_RUN_TILES(FIRST, LAST, GWI, NGWI) do { \
        f32x4 va[16], vb[16]; \
        int it = (FIRST) + (GWI); \
        if (it < (LAST)) { P0Tile ta = tile_of(it, lane); p0_tile_load(ta, lane, va); \
            for (;;) { \
                const int itb = it + (NGWI); P0Tile tb = ta; const bool hb = itb < (LAST); \
                if (hb) { tb = tile_of(itb, lane); p0_tile_load(tb, lane, vb); } \
                p0_tile_store(ta, lane, va, scr); \
                if (!hb) break; \
                const int ita = itb + (NGWI); const bool ha = ita < (LAST); \
                if (ha) { ta = tile_of(ita, lane); p0_tile_load(ta, lane, va); } \
                p0_tile_store(tb, lane, vb, scr); \
                if (!ha) break; \
                it = ita; \
            } \
        } } while (0)
    if (IN(0)) for (int rep_ = 0; rep_ < DUPN(0); ++rep_) {
        PHASE_IDS();
        LAS float* scr = (LAS float*)(lds + wave * 17408);
        P0_RUN_TILES(0, I_IN, gw, NGW);
        for (int row = gw; row < T; row += NGW) {
            const float4* xr = (const float4*)(x + (size_t)row * DM);
            float4 v[16]; float ss = 0.f;
#pragma unroll
            for (int j = 0; j < 16; ++j) { const f32x4 t_ = __builtin_nontemporal_load((const f32x4*)xr + lane + 64 * j); v[j] = make_float4(t_[0], t_[1], t_[2], t_[3]); ss += v[j].x * v[j].x + v[j].y * v[j].y + v[j].z * v[j].z + v[j].w * v[j].w; }
            ss = wave_sum(ss);
            const float rs = rsqrtf(ss * (1.f / DM) + EPS);
            uint2* o = (uint2*)(XN + (size_t)row * DM); unsigned* o8 = (unsigned*)(ws + WS_XN8 + (size_t)row * DM);
#pragma unroll
            for (int j = 0; j < 16; ++j) { const float4 gg = ((const float4*)pre_norm)[lane + 64 * j];
                const float n0 = v[j].x * rs * gg.x, n1 = v[j].y * rs * gg.y, n2 = v[j].z * rs * gg.z, n3 = v[j].w * rs * gg.w;
                uint2 w; w.x = pk2(n0, n1); w.y = pk2(n2, n3); o[lane + 64 * j] = w;
                int q8 = 0; q8 = __builtin_amdgcn_cvt_pk_fp8_f32(n0, n1, q8, false); q8 = __builtin_amdgcn_cvt_pk_fp8_f32(n2, n3, q8, true); o8[lane + 64 * j] = (unsigned)q8; }
        }
    }
    SEAM(0);
    if (IN(1)) for (int rep_ = 0; rep_ < DUPN(1); ++rep_) {
        constexpr int NUB = (T / 256) * NTB, NU8 = (T / 256) * NT8;
        { pg8::Gemm g{XN, WIN, DM, DM, DM, 0, 0}; pg8::StaticOrder So; So.init(T, NTB * 256, G, bx); So.p0 = 10; So.rs = 5; So.ra = 8;
          pg8::EpiStore E{Z, ZP, 1.f};
          pg8::gemm_phase<pg8::EpiStore, true, true>(lds, wave0, g, So, E); }
        { pg8::Gemm g{(const bf16_t*)(ws + WS_XN8), (const bf16_t*)(ws + WS_W8), DM / 2, DM / 2, DM / 2, 0, 0}; pg8::StaticOrder So; So.init(T, NT8 * 256, G, bx); So.p0 = 0; So.rs = 10; So.ra = 5;
          if (G == 256) { So.nfb = NUB - 2 * 256; So.nl = 256 - So.nfb; So.kl = 4; }
          pg8::EpiStore E{Z, ZP, 1.f / 64.f};
          pg8::gemm_phase<pg8::EpiStore, true, true, 1>(lds, wave0, g, So, E); }
    }
    if (IN(1)) {
        PHASE_IDS();
        constexpr int NUB = (T / 256) * NTB, NU8 = (T / 256) * NT8;
        int nhelp = G, hidx = bx;
        if (G == 256) { constexpr int nfb = NUB - 2 * 256, h0 = NU8 - 4 * (256 - nfb) - nfb; static_assert(nfb == 160 && h0 == 32, "unit hand-out"); nhelp = nfb - h0; hidx = (bx >= h0 && bx < nfb) ? bx - h0 : -1; }
        if (hidx >= 0) {
            LAS float* scr = (LAS float*)(lds + wave * 17408);
            const int gwi = hidx * NWAVES + wave, ngwi = nhelp * NWAVES;
            P0_RUN_TILES(I_IN, I_T, gwi, ngwi);
            for (int it = gwi; it < 2048; it += ngwi) {
                const float4* p = (const float4*)(w_uk + (size_t)it * 512 + lane * 8); const float4 v0 = p[0], v1 = p[1];
                uint4 o; o.x = pk2(v0.x, v0.y); o.y = pk2(v0.z, v0.w); o.z = pk2(v1.x, v1.y); o.w = pk2(v1.z, v1.w); *(uint4*)(WUK + (size_t)it * 512 + lane * 8) = o; }
        }
    }
    SEAM(1);
    if (IN(2)) for (int rep_ = 0; rep_ < DUPN(2); ++rep_) {
        PHASE_IDS();
        for (int row = gw; row < T; row += NGW) {
            const bf16_t* zr = Z + (size_t)row * ZP;
            { const uint4 u = *(const uint4*)(zr + ZC + lane * 8);
              const float c0 = bflo(u.x), c1 = bfhi(u.x), c2 = bflo(u.y), c3 = bfhi(u.y), c4 = bflo(u.z), c5 = bfhi(u.z), c6 = bflo(u.w), c7 = bfhi(u.w);
              float ss = (c0 * c0 + c1 * c1) + (c2 * c2 + c3 * c3) + (c4 * c4 + c5 * c5) + (c6 * c6 + c7 * c7);
              ss = wave_sum(ss); const float rs = rsqrtf(ss * (1.f / 512.f) + EPS);
              const float4 g0 = ((const float4*)kv_norm)[lane * 2], g1 = ((const float4*)kv_norm)[lane * 2 + 1];
              int lo = 0, hi = 0;
              lo = __builtin_amdgcn_cvt_pk_fp8_f32(c0 * rs * g0.x, c1 * rs * g0.y, lo, false); lo = __builtin_amdgcn_cvt_pk_fp8_f32(c2 * rs * g0.z, c3 * rs * g0.w, lo, true);
              hi = __builtin_amdgcn_cvt_pk_fp8_f32(c4 * rs * g1.x, c5 * rs * g1.y, hi, false); hi = __builtin_amdgcn_cvt_pk_fp8_f32(c6 * rs * g1.z, c7 * rs * g1.w, hi, true);
              uint2 o; o.x = (unsigned)lo; o.y = (unsigned)hi;
              *(uint2*)((unsigned char*)CN + (size_t)row * 512 + lane * 8) = o; }
            { const float v = bf2f(zr[ZKIX + lane]); const float mu = wave_sum(v) * (1.f / 64.f); const float d = v - mu; const float var = wave_sum(d * d) * (1.f / 64.f);
              KIXN[(size_t)row * 64 + lane] = f2bf(d * rsqrtf(var + EPS) * kg[lane] + kb[lane]); }
            if (lane < 16) WIX[(size_t)row * 16 + lane] = bf2f(zr[ZWIX + lane]) * 0.25f;
        }
        for (int run = vcu * 2 + (tid >> 8); run < T / 16; run += 2 * G) {
            const int cs = tid & 255, t0 = run * 16, pos0 = t0 & (S - 1), g_ = cs >> 6, w = 2 << g_;
            const bf16_t* zc = Z + ZPI + cs * 8;
            float s0 = 0.f, s1 = 0.f, s2 = 0.f, s3 = 0.f, s4 = 0.f, s5 = 0.f, s6 = 0.f, s7 = 0.f;
            const int nh = (w - 1) < pos0 ? (w - 1) : pos0;
            for (int hh = 1; hh <= nh; ++hh) { const uint4 u = *(const uint4*)(zc + (size_t)(t0 - hh) * ZP);
                s0 += bflo(u.x); s1 += bfhi(u.x); s2 += bflo(u.y); s3 += bfhi(u.y); s4 += bflo(u.z); s5 += bfhi(u.z); s6 += bflo(u.w); s7 += bfhi(u.w); }
#pragma unroll 4
            for (int i = 0; i < 16; ++i) {
                const int t = t0 + i, pos = pos0 + i;
                const uint4 u = *(const uint4*)(zc + (size_t)t * ZP);
                const bool drop = i > 0 && pos >= w;
                uint4 od = make_uint4(0u, 0u, 0u, 0u); if (drop) od = *(const uint4*)(zc + (size_t)(t - w) * ZP);
                s0 += bflo(u.x) - bflo(od.x); s1 += bfhi(u.x) - bfhi(od.x); s2 += bflo(u.y) - bflo(od.y); s3 += bfhi(u.y) - bfhi(od.y);
                s4 += bflo(u.z) - bflo(od.z); s5 += bfhi(u.z) - bfhi(od.z); s6 += bflo(u.w) - bflo(od.w); s7 += bfhi(u.w) - bfhi(od.w);
                const int cnt = (pos + 1) < w ? (pos + 1) : w; const float inv = 1.f / (float)cnt;
                uint4 o; o.x = pk2(s0 * inv - bflo(u.x), s1 * inv - bfhi(u.x)); o.y = pk2(s2 * inv - bflo(u.y), s3 * inv - bfhi(u.y));
                o.z = pk2(s4 * inv - bflo(u.z), s5 * inv - bfhi(u.z)); o.w = pk2(s6 * inv - bflo(u.w), s7 * inv - bfhi(u.w));
                *(uint4*)(MIX + (size_t)t * 2048 + cs * 8) = o;
            }
        }
    }
    SEAM(2);
    if (DUPN(9) > 1) for (int e_ = 0; e_ < 8; ++e_) { const int _l = lane_id(); xcd_barrier(xbar, xcc, (unsigned)G, xst, wave0 == 0 && _l == 0); }
    if (IN(3)) for (int rep_ = 0; rep_ < DUPN(3); ++rep_) {
        {
            PHASE_IDS();
            const int g = lane >> 4, hl = lane & 15;
            for (int tk = vcu; tk < 256; tk += G) {
                const int h = tk & 15, rr = tk >> 4;
                __syncthreads();
#pragma unroll 4
                for (int i = 0; i < 16; ++i) { const int r0 = (wave * 16 + i) * 4, r = r0 + (lane >> 4), sw = (((r >> 4) & 3) << 2) | (r & 3);
                    const unsigned char* srcp = (const unsigned char*)WUK + (size_t)(h * 512 + r) * 256 + (((lane & 15) ^ sw) << 4);
                    __builtin_amdgcn_global_load_lds((const unsigned*)srcp, (LAS unsigned*)(lds + r0 * 256), 16, 0, 0); }
                asm volatile("s_waitcnt vmcnt(0)" ::: "memory"); __syncthreads();
                const unsigned abase = (unsigned)(size_t)lds + (unsigned)((16 * (hl >> 2) + (hl & 3)) * 256 + ((g ^ hl) << 4));
                bf16x8 qB[4];
                { const bf16_t* qp = Z + (size_t)(rr * 512 + wave * 16 + hl) * ZP + ZQ + h * 128 + g * 8;
#pragma unroll
                  for (int ks = 0; ks < 4; ++ks) qB[ks] = *(const bf16x8*)(qp + ks * 32); }
                for (int rg = wave; rg < 32; rg += NWAVES) {
                    const int t0 = rr * 512 + rg * 16, rgn = rg + NWAVES < 32 ? rg + NWAVES : rg;
                    bf16x8 qN[4];
                    { const bf16_t* qp = Z + (size_t)(rr * 512 + rgn * 16 + hl) * ZP + ZQ + h * 128 + g * 8;
#pragma unroll
                      for (int ks = 0; ks < 4; ++ks) qN[ks] = *(const bf16x8*)(qp + ks * 32); }
                    unsigned char* orow = (unsigned char*)QL + (size_t)(t0 + hl) * 16384 + h * 512 + 16 * g;
#pragma unroll 2
                    for (int cb = 0; cb < 8; ++cb) {
                        f32x4 acc[4];
#pragma unroll
                        for (int j = 0; j < 4; ++j) { acc[j] = (f32x4){0.f, 0.f, 0.f, 0.f};
#pragma unroll
                            for (int ks = 0; ks < 4; ++ks) {
                                const unsigned ad = (abase & ~0xF0u) + cb * 16384 + j * 1024 + ((((unsigned)(ks * 4 + g)) ^ (unsigned)hl) << 4);
                                const bf16x8 a = *(const LAS bf16x8*)(size_t)ad;
                                acc[j] = __builtin_amdgcn_mfma_f32_16x16x32_bf16(a, qB[ks], acc[j], 0, 0, 0); } }
                        u32x4 w;
                        { int d0 = 0, d1 = 0, d2 = 0, d3 = 0;
                          d0 = __builtin_amdgcn_cvt_pk_fp8_f32(acc[0][0], acc[0][1], d0, false); d0 = __builtin_amdgcn_cvt_pk_fp8_f32(acc[0][2], acc[0][3], d0, true);
                          d1 = __builtin_amdgcn_cvt_pk_fp8_f32(acc[1][0], acc[1][1], d1, false); d1 = __builtin_amdgcn_cvt_pk_fp8_f32(acc[1][2], acc[1][3], d1, true);
                          d2 = __builtin_amdgcn_cvt_pk_fp8_f32(acc[2][0], acc[2][1], d2, false); d2 = __builtin_amdgcn_cvt_pk_fp8_f32(acc[2][2], acc[2][3], d2, true);
                          d3 = __builtin_amdgcn_cvt_pk_fp8_f32(acc[3][0], acc[3][1], d3, false); d3 = __builtin_amdgcn_cvt_pk_fp8_f32(acc[3][2], acc[3][3], d3, true);
                          w.x = (unsigned)d0; w.y = (unsigned)d1; w.z = (unsigned)d2; w.w = (unsigned)d3; }
                        *(u32x4*)(orow + cb * 64) = w;
                    }
#pragma unroll
                    for (int ks = 0; ks < 4; ++ks) qB[ks] = qN[ks];
                }
            }
            __syncthreads();
        }
        { pg8::Gemm g{MIX, WPOOL, 2048, 512, 512, 1, 512}; pg8::StaticOrder So; So.init(T, 2048, G, bx);
          pg8::EpiGate E{CAT, 3072, 1024, Z, ZGB, pool_scale};
          for (int r2_ = 0; r2_ < DUPN(11); ++r2_) pg8::gemm_phase<pg8::EpiGate, true, true>(lds, wave0, g, So, E); }
    }
    if (IN(3)) for (int rep_ = 0; rep_ < DUPN(4); ++rep_) {
        PHASE_IDS();
        constexpr int SCP = 2052;
        LAS float* sc = (LAS float*)lds;
        unsigned short* SEL = (unsigned short*)(ws + WS_SEL);
        for (int k0 = vcu; k0 < 256; k0 += G)
        for (int side = 0; side < 2; ++side) {
            const int uu = side == 0 ? k0 : 511 - k0;
            const int j = uu >> 4, r_ = uu & 15, b = r_ >> 2, q4 = r_ & 3;
            const int t0 = b * S + j * 64 + q4 * 16, N = (j + 1) * 64;
            int lo_ = lane; asm volatile("" : "+v"(lo_));
            const int g = lo_ >> 4, hl = lo_ & 15;
            if (N <= 256) {
#pragma unroll
                for (int qq = 0; qq < 2; ++qq) { unsigned short* so = SEL + (size_t)(t0 + wave * 2 + qq) * 256;
#pragma unroll
                    for (int k = 0; k < 4; ++k) so[lo_ + 64 * k] = (unsigned short)(lo_ + 64 * k); }
                continue;
            }
            for (int r12_ = 0; r12_ < DUPN(12); ++r12_)
            {
                bf16x8 qb[16][2];
                const bf16_t* qrow = Z + (size_t)(t0 + hl) * ZP + ZQI + g * 8;
#pragma unroll
                for (int h = 0; h < 16; ++h) { qb[h][0] = *(const bf16x8*)(qrow + h * 64); qb[h][1] = *(const bf16x8*)(qrow + h * 64 + 32); }
                float wq[16];
                { const float4* wp = (const float4*)(WIX + (size_t)(t0 + hl) * 16);
#pragma unroll
                  for (int k = 0; k < 4; ++k) { const float4 w4 = wp[k]; wq[4 * k] = w4.x * 0.125f; wq[4 * k + 1] = w4.y * 0.125f; wq[4 * k + 2] = w4.z * 0.125f; wq[4 * k + 3] = w4.w * 0.125f; } }
                bf16x8 qsh[2], qsl[2];
#pragma unroll
                for (int ks = 0; ks < 2; ++ks) { float qs[8];
#pragma unroll
                    for (int e = 0; e < 8; ++e) qs[e] = 0.f;
#pragma unroll
                    for (int h = 0; h < 16; ++h)
#pragma unroll
                        for (int e = 0; e < 8; ++e) qs[e] += wq[h] * bf2f((bf16_t)qb[h][ks][e]);
#pragma unroll
                    for (int e = 0; e < 8; ++e) { const bf16_t hi = f2bf(qs[e]); qsh[ks][e] = (short)hi; qsl[ks][e] = (short)f2bf(qs[e] - bf2f(hi)); } }
                const int ntile = N >> 4;
                int kt = wave;
                const bf16_t* krow = KIXN + (size_t)(b * S + hl) * 64 + g * 8;
                bf16x8 a0 = *(const bf16x8*)(krow + (size_t)kt * 1024), a1 = *(const bf16x8*)(krow + (size_t)kt * 1024 + 32);
                for (; kt < ntile; kt += NWAVES) {
                    const int kn = (kt + NWAVES < ntile) ? kt + NWAVES : kt;
                    const bf16x8 n0 = *(const bf16x8*)(krow + (size_t)kn * 1024), n1 = *(const bf16x8*)(krow + (size_t)kn * 1024 + 32);
                    f32x4 dl = __builtin_amdgcn_mfma_f32_16x16x32_bf16(a0, qsh[0], (f32x4){0.f, 0.f, 0.f, 0.f}, 0, 0, 0);
                    dl = __builtin_amdgcn_mfma_f32_16x16x32_bf16(a1, qsh[1], dl, 0, 0, 0);
                    dl = __builtin_amdgcn_mfma_f32_16x16x32_bf16(a0, qsl[0], dl, 0, 0, 0);
                    dl = __builtin_amdgcn_mfma_f32_16x16x32_bf16(a1, qsl[1], dl, 0, 0, 0);
                    float c0_ = 0.f, c1_ = 0.f, c2_ = 0.f, c3_ = 0.f;
#pragma unroll
                    for (int h = 0; h < 16; ++h) {
                        f32x4 d = __builtin_amdgcn_mfma_f32_16x16x32_bf16(a0, qb[h][0], (f32x4){0.f, 0.f, 0.f, 0.f}, 0, 0, 0);
                        d = __builtin_amdgcn_mfma_f32_16x16x32_bf16(a1, qb[h][1], d, 0, 0, 0);
                        c0_ = __builtin_fmaf(__builtin_fabsf(d[0]), wq[h], c0_); asm("" : "+v"(c0_));
                        c1_ = __builtin_fmaf(__builtin_fabsf(d[1]), wq[h], c1_); asm("" : "+v"(c1_));
                        c2_ = __builtin_fmaf(__builtin_fabsf(d[2]), wq[h], c2_); asm("" : "+v"(c2_));
                        c3_ = __builtin_fmaf(__builtin_fabsf(d[3]), wq[h], c3_); asm("" : "+v"(c3_));
                    }
                    *(LAS f32x4*)(sc + hl * SCP + kt * 16 + 4 * g) = (f32x4){0.5f * (dl[0] + c0_), 0.5f * (dl[1] + c1_), 0.5f * (dl[2] + c2_), 0.5f * (dl[3] + c3_)};
                    a0 = n0; a1 = n1;
                }
            }
            __syncthreads();
            const int ni = N >> 6;
            for (int r13_ = 0; r13_ < DUPN(13); ++r13_)
            for (int qq = 0; qq < 2; ++qq) {
                const int q = wave * 2 + qq;
                int lq = lane; asm volatile("" : "+v"(lq));
                unsigned u[32];
#pragma unroll
                for (int i = 0; i < 32; ++i) { u[i] = 0u;
                    if (i < ni) { const unsigned bits = __float_as_uint(sc[q * SCP + i * 64 + lq]); u[i] = bits ^ ((bits >> 31) ? 0xFFFFFFFFu : 0x80000000u); } }
                unsigned Tt = 0u;
                for (int bit = 31; bit >= 0; --bit) {
                    const unsigned cand = Tt | (1u << bit); int cnt = 0;
#pragma unroll
                    for (int i8 = 0; i8 < 4; ++i8) if (i8 * 8 < ni) {
                        cnt += count_ge8(u[i8 * 8], u[i8 * 8 + 1], u[i8 * 8 + 2], u[i8 * 8 + 3], u[i8 * 8 + 4], u[i8 * 8 + 5], u[i8 * 8 + 6], u[i8 * 8 + 7], cand); }
                    if (cnt >= 256) Tt = cand;
                    if (cnt == 256) break;
                }
                unsigned short* so = SEL + (size_t)(t0 + q) * 256;
                const unsigned long long lt = (1ull << lq) - 1ull;
                int base = 0;
#pragma unroll
                for (int i = 0; i < 32; ++i) if (i < ni) { const bool pr = u[i] > Tt; const unsigned long long mk = __ballot(pr);
                    if (pr) so[base + __builtin_popcountll(mk & lt)] = (unsigned short)(i * 64 + lq); base += __builtin_popcountll(mk); }
#pragma unroll
                for (int i = 0; i < 32; ++i) if (i < ni) { const bool pr = u[i] == Tt; const unsigned long long mk = __ballot(pr);
                    const int ps = base + __builtin_popcountll(mk & lt); if (pr && ps < 256) so[ps] = (unsigned short)(i * 64 + lq); base += __builtin_popcountll(mk); }
            }
            __syncthreads();
        }
    }
    if (IN(3) && IN(5)) { const int _l = lane_id(); xcd_barrier(xbar, xcc, (unsigned)G, xst, wave0 == 0 && _l == 0); }
    if (IN(5)) for (int rep_ = 0; rep_ < DUPN(5); ++rep_) {
        PHASE_IDS();
        const int g = lane >> 4, hl = lane & 15;
        const unsigned short* SEL = (const unsigned short*)(ws + WS_SEL);
        LAS unsigned char* reg = lds + wave * 16384;
#define FSW8(s) ((((s) & 15) ^ (((s) & 16) >> 1)))
        const unsigned regb = (unsigned)(size_t)reg;
        unsigned xb0;
        { const int f0 = FSW8(hl);
          xb0 = regb + (unsigned)(hl * 512 + (((2 * g) ^ f0) << 4)); }
        unsigned yb;
        { const int q = hl >> 1, p = hl & 1, rq = q < 4 ? 4 * g + q : 16 + 4 * g + (q - 4), f = FSW8(rq); yb = regb + (unsigned)(rq * 512 + (f << 4) + 8 * p); }
        unsigned lhalf = (unsigned)(lane >> 5), lbase = (((unsigned)(lane & 31)) ^ lhalf) << 4;
        const float SCL = 0.08838834764831845f * 1.4426950408889634f;
        for (int wq = gw; wq < 2048; wq += NGW) {
            const int b = wq >> 9, widx = wq & 511;
            const unsigned char* cbase = (const unsigned char*)CN + (size_t)b * S * 512;
            typedef int v8i __attribute__((ext_vector_type(8)));
            v8i qf[4];
            { const unsigned char* qrow = (const unsigned char*)QL + (size_t)(b * S + widx) * 16384 + hl * 512 + g * 32;
#pragma unroll
              for (int kk = 0; kk < 4; ++kk) qf[kk] = *(const v8i*)(qrow + kk * 128); }
            for (int i4 = 0; i4 < 4; ++i4) {
                const int pos = i4 * 512 + widx, t = b * S + pos;
                const int N = ((pos >> 6) + 1) * 64, nv = N < 256 ? N : 256, nw = nv >> 6;
                f32x4 O[32];
#pragma unroll
                for (int n = 0; n < 32; ++n) O[n] = (f32x4){0.f, 0.f, 0.f, 0.f};
                float m = -1e30f, lsum = 0.f;
#define P5_KEYS(KV, KQ) do { _Pragma("unroll") for (int d2 = 0; d2 < 8; ++d2) { \
                    const unsigned pA = (unsigned)__builtin_amdgcn_readlane((KV), (KQ) * 32 + 4 * d2) | ((unsigned)__builtin_amdgcn_readlane((KV), (KQ) * 32 + 4 * d2 + 2) << 16); \
                    const unsigned pB = (unsigned)__builtin_amdgcn_readlane((KV), (KQ) * 32 + 4 * d2 + 1) | ((unsigned)__builtin_amdgcn_readlane((KV), (KQ) * 32 + 4 * d2 + 3) << 16); \
                    kp[d2] = lhalf ? pB : pA; } } while (0)
                unsigned kp[8];
                int kcur = (int)SEL[(size_t)t * 256 + lane];
                P5_KEYS(kcur, 0);
                for (int w = 0; w < nw; ++w) {
                    const int knext = (w + 1 < nw) ? (int)SEL[(size_t)t * 256 + (w + 1) * 64 + lane] : kcur;
                    for (int kq = 0; kq < 2; ++kq) {
                        asm volatile("s_waitcnt lgkmcnt(0)" : "+v"(lbase), "+v"(lhalf), "+v"(xb0), "+v"(yb) :: "memory");
#pragma unroll
                        for (int d = 0; d < 16; ++d) { const unsigned key = (d & 1) ? (kp[d >> 1] >> 16) : (kp[d >> 1] & 0xffffu);
                            __builtin_amdgcn_global_load_lds((const unsigned*)(cbase + (size_t)((lbase ^ (unsigned)(((((2 * d) & 15) ^ (d >= 8 ? 8 : 0))) << 4)) + (key << 9))), (LAS unsigned*)(reg + d * 1024), 16, 0, 0); }
                        asm volatile("s_waitcnt vmcnt(8)" ::: "memory");
                        f32x4 sT0 = (f32x4){0.f, 0.f, 0.f, 0.f}, sT1 = (f32x4){0.f, 0.f, 0.f, 0.f};
#pragma unroll
                        for (int kk = 0; kk < 4; ++kk) {
                            const unsigned ad = (xb0 ^ (unsigned)((kk & 1) << 7)) + (kk >> 1) * 256;
                            const u32x4 lo = *(const LAS u32x4*)(size_t)ad, hi = *(const LAS u32x4*)(size_t)(ad ^ 16u);
                            const v8i a0 = (v8i){(int)lo.x, (int)lo.y, (int)lo.z, (int)lo.w, (int)hi.x, (int)hi.y, (int)hi.z, (int)hi.w};
                            sT0 = __builtin_amdgcn_mfma_scale_f32_16x16x128_f8f6f4(a0, qf[kk], sT0, 0, 0, 0, 0, 0, 0);
                        }
                        asm volatile("s_waitcnt vmcnt(0)" ::: "memory");
#pragma unroll
                        for (int kk = 0; kk < 4; ++kk) {
                            const unsigned ad = (xb0 ^ (unsigned)(((kk & 1) << 7) ^ 128)) + 8192 + (kk >> 1) * 256;
                            const u32x4 lo = *(const LAS u32x4*)(size_t)ad, hi = *(const LAS u32x4*)(size_t)(ad ^ 16u);
                            const v8i a1 = (v8i){(int)lo.x, (int)lo.y, (int)lo.z, (int)lo.w, (int)hi.x, (int)hi.y, (int)hi.z, (int)hi.w};
                            sT1 = __builtin_amdgcn_mfma_scale_f32_16x16x128_f8f6f4(a1, qf[kk], sT1, 0, 0, 0, 0, 0, 0);
                        }
                        if (w == nw - 1 && kq == 1 && i4 < 3) {
                            const unsigned char* qrow = (const unsigned char*)QL + (size_t)(t + 512) * 16384 + hl * 512 + g * 32;
#pragma unroll
                            for (int kk = 0; kk < 4; ++kk) qf[kk] = *(const v8i*)(qrow + kk * 128); }
                        const float s0 = sT0[0] * SCL, s1 = sT0[1] * SCL, s2 = sT0[2] * SCL, s3 = sT0[3] * SCL, s4 = sT1[0] * SCL, s5 = sT1[1] * SCL, s6 = sT1[2] * SCL, s7 = sT1[3] * SCL;
                        float mx = fmaxf(fmaxf(fmaxf(s0, s1), fmaxf(s2, s3)), fmaxf(fmaxf(s4, s5), fmaxf(s6, s7)));
                        { const unsigned mu = __float_as_uint(mx); const auto r16 = __builtin_amdgcn_permlane16_swap(mu, mu, false, false);
                          mx = fmaxf(__uint_as_float(r16[0]), __uint_as_float(r16[1]));
                          const unsigned mv = __float_as_uint(mx); const auto r32 = __builtin_amdgcn_permlane32_swap(mv, mv, false, false);
                          mx = fmaxf(__uint_as_float(r32[0]), __uint_as_float(r32[1])); }
                        if (!__all(mx - m <= 6.f)) {
                            const float mn = fmaxf(m, mx), alpha = __builtin_amdgcn_exp2f(m - mn); m = mn; lsum *= alpha;
#pragma unroll
                            for (int n = 0; n < 32; ++n) O[n] = O[n] * alpha;
                        }
                        const float p0 = __builtin_amdgcn_exp2f(s0 - m), p1 = __builtin_amdgcn_exp2f(s1 - m), p2 = __builtin_amdgcn_exp2f(s2 - m), p3 = __builtin_amdgcn_exp2f(s3 - m), p4 = __builtin_amdgcn_exp2f(s4 - m), p5 = __builtin_amdgcn_exp2f(s5 - m), p6 = __builtin_amdgcn_exp2f(s6 - m), p7 = __builtin_amdgcn_exp2f(s7 - m);
                        lsum += ((p0 + p1) + (p2 + p3)) + ((p4 + p5) + (p6 + p7));
                        int plo = 0, phi = 0;
                        plo = __builtin_amdgcn_cvt_pk_fp8_f32(p0, p1, plo, false); plo = __builtin_amdgcn_cvt_pk_fp8_f32(p2, p3, plo, true);
                        phi = __builtin_amdgcn_cvt_pk_fp8_f32(p4, p5, phi, false); phi = __builtin_amdgcn_cvt_pk_fp8_f32(p6, p7, phi, true);
                        const long pf = ((long)phi << 32) | (unsigned)plo;
                        if (kq == 0) P5_KEYS(kcur, 1); else P5_KEYS(knext, 0);
#pragma unroll
                        for (int n = 0; n < 32; ++n) {
                            typedef int v2i __attribute__((ext_vector_type(2)));
                            const v2i tr = __builtin_amdgcn_ds_read_tr8_b64_v2i32((LAS v2i*)((size_t)(yb ^ (unsigned)((n & 15) << 4)) + (n >> 4) * 256));
                            const long ct = ((long)tr[1] << 32) | (unsigned)tr[0];
                            O[n] = __builtin_amdgcn_mfma_f32_16x16x32_fp8_fp8(ct, pf, O[n], 0, 0, 0);
                        }
                    }
                    kcur = knext;
                }
#undef P5_KEYS
                float lt = lsum + __shfl_xor(lsum, 16); lt += __shfl_xor(lt, 32);
                const float inv = 16.f / lt;
                unsigned wbase = (unsigned)(hl * 512 + (hl << 4) + 4 * g);
                unsigned lx = (unsigned)((lane >> 5) * 512 + (((lane & 31) ^ (lane >> 5)) << 4));
                asm volatile("s_waitcnt lgkmcnt(0)" : "+v"(wbase), "+v"(lx) :: "memory");
#pragma unroll
                for (int n = 0; n < 32; ++n) { const f32x4 o = O[n] * inv; int w = 0;
                    w = __builtin_amdgcn_cvt_pk_fp8_f32(o[0], o[1], w, false); w = __builtin_amdgcn_cvt_pk_fp8_f32(o[2], o[3], w, true);
                    *(LAS unsigned*)(reg + (wbase ^ (unsigned)(n << 4))) = (unsigned)w; }
                asm volatile("s_waitcnt lgkmcnt(0)" ::: "memory");
                { unsigned char* orow = (rep_ > 0 ? ws + WS_WIN + (size_t)gw * 16384 : (unsigned char*)QL + (size_t)t * 16384) + lane * 16;
#pragma unroll
                  for (int h2 = 0; h2 < 8; ++h2) { const u32x4 v = *(const LAS u32x4*)(reg + h2 * 1024 + (lx ^ (unsigned)(h2 << 5))); *(u32x4*)(orow + h2 * 1024) = v; } }
            }
        }
#undef FSW8
    }
    SEAM(5);
    if (IN(6)) for (int rep_ = 0; rep_ < DUPN(6); ++rep_) {
        pg8::Gemm g{QL, WUV2, 8192, 512, 512, 0, 512}; pg8::StaticOrder So; So.init(T, 2048, G, bx);
        pg8::EpiGate8 E{(unsigned char*)CAT, 6144, Z, ZGA, 1.f / 64.f};
        pg8::gemm_phase<pg8::EpiGate8, true, true, 1>(lds, wave0, g, So, E);
    }
    SEAM(6);
    const bool fuse8 = (G == 256) && IN(7) && IN(8) && DUPN(7) == 1;
    if (IN(7)) for (int rep_ = 0; rep_ < DUPN(7); ++rep_) {
        pg8::Gemm g{CAT, WOUT, 3072, 3072, 3072, 0, 0, 16, 1.f / 1024.f}; pg8::StaticOrder So; So.init(T, DM, G, bx);
        if (fuse8) { const int _l = lane_id();
            EpiOutF E{Y, RSS, x, post_norm, a.out, xbar, xcc, (unsigned)G, xst};
            pg8::gemm_phase<EpiOutF, true, true, 2>(lds, wave0, g, So, E); (void)_l; }
        else { pg8::EpiOut E{Y, RSS};
            pg8::gemm_phase<pg8::EpiOut, true, true, 2>(lds, wave0, g, So, E); }
    }
    if (!fuse8) SEAM(7);
    if (IN(8)) for (int rep_ = 0; rep_ < DUPN(8); ++rep_) {
        PHASE_IDS();
        for (int row = gw; row < T; row += NGW) {
            const float ss = wave_sum(RSS[(size_t)row * 64 + lane]);
            const float rs = rsqrtf(ss * (1.f / DM) + EPS);
            const uint4* yr = (const uint4*)(Y + (size_t)row * DM);
#pragma unroll
            for (int j = 0; j < 8; ++j) { if (fuse8 && (j & 2)) continue;
                const u32x4 u_ = __builtin_nontemporal_load((const u32x4*)yr + lane + 64 * j); const uint4 u = make_uint4(u_.x, u_.y, u_.z, u_.w); const size_t c = (size_t)(lane + 64 * j) * 8;
                const float4* xp = (const float4*)(x + (size_t)row * DM + c); const float4* gp = (const float4*)(post_norm + c);
                const f32x4 xa_ = __builtin_nontemporal_load((const f32x4*)xp), xb_ = __builtin_nontemporal_load((const f32x4*)xp + 1);
                const float4 x0 = make_float4(xa_[0], xa_[1], xa_[2], xa_[3]), x1 = make_float4(xb_[0], xb_[1], xb_[2], xb_[3]), g0 = gp[0], g1 = gp[1]; float4 o0, o1;
                o0.x = x0.x + bflo(u.x) * rs * g0.x; o0.y = x0.y + bfhi(u.x) * rs * g0.y; o0.z = x0.z + bflo(u.y) * rs * g0.z; o0.w = x0.w + bfhi(u.y) * rs * g0.w;
                o1.x = x1.x + bflo(u.z) * rs * g1.x; o1.y = x1.y + bfhi(u.z) * rs * g1.y; o1.z = x1.z + bflo(u.w) * rs * g1.z; o1.w = x1.w + bfhi(u.w) * rs * g1.w;
                float4* op = (float4*)(a.out + (size_t)row * DM + c); op[0] = o0; op[1] = o1; }
        }
    }
#undef IN
#undef SEAM
}

extern "C" void kernel_launch(void* const* d_in, const int* in_sizes, int n_in, void* d_out, int out_size, void* d_ws, size_t ws_size, hipStream_t stream) {
    if (n_in != 12 || in_sizes[0] != T * DM || out_size != T * DM || ws_size < WS_END) { fprintf(stderr, "kernel_launch: unexpected shapes/ws (%d %d %d %zu)\n", n_in, n_in > 0 ? in_sizes[0] : -1, out_size, ws_size); return; }
    const float* x = (const float*)d_in[0]; const float* pre_norm = (const float*)d_in[1]; const float* w_in = (const float*)d_in[2]; const float* kv_norm = (const float*)d_in[3];
    const float* w_uk = (const float*)d_in[4]; const float* w_uv = (const float*)d_in[5]; const float* kg = (const float*)d_in[6]; const float* kb = (const float*)d_in[7];
    const float* w_pool = (const float*)d_in[8]; const float* pool_scale = (const float*)d_in[9]; const float* w_out = (const float*)d_in[10]; const float* post_norm = (const float*)d_in[11];
    unsigned char* ws = (unsigned char*)d_ws; float* out = (float*)d_out;
    bf16_t* H = (bf16_t*)(ws + WS_XN); bf16_t* CAT = (bf16_t*)(ws + WS_XN); bf16_t* Z = (bf16_t*)(ws + WS_Z); bf16_t* CN = (bf16_t*)(ws + WS_CN); bf16_t* KIXN = (bf16_t*)(ws + WS_KIXN);
    float* WIX = (float*)(ws + WS_WIX); unsigned short* SEL = (unsigned short*)(ws + WS_SEL); bf16_t* MIX = (bf16_t*)(ws + WS_WIN); bf16_t* Y = (bf16_t*)(ws + WS_WIN); bf16_t* QL = (bf16_t*)(ws + WS_QL);

    static int grid_blocks = 0;
    if (grid_blocks == 0) {
        int dev = 0, cus = 0, per_cu = 0;
        if (hipGetDevice(&dev) != hipSuccess || hipDeviceGetAttribute(&cus, hipDeviceAttributeMultiprocessorCount, dev) != hipSuccess) { fprintf(stderr, "kernel_launch: device query failed\n"); grid_blocks = -1; return; }
        if (hipFuncSetAttribute((const void*)mk_fwd, hipFuncAttributeMaxDynamicSharedMemorySize, LDS_BYTES) != hipSuccess) { fprintf(stderr, "kernel_launch: hipFuncSetAttribute failed\n"); grid_blocks = -1; return; }
        if (hipOccupancyMaxActiveBlocksPerMultiprocessor(&per_cu, (const void*)mk_fwd, NWAVES * 64, LDS_BYTES) != hipSuccess || per_cu < 1) { fprintf(stderr, "kernel_launch: occupancy query failed (%d)\n", per_cu); grid_blocks = -1; return; }
        grid_blocks = cus * per_cu;
        fprintf(stderr, "kernel_launch: %d CUs x %d blocks/CU = grid %d\n", cus, per_cu, grid_blocks);
    }
    if (grid_blocks < 0) return;
    auto launch_mk = [&](int lo, int hi) {
        MkArgs a{}; for (int i = 0; i < 12; ++i) a.in[i] = (const float*)d_in[i]; a.out = out; a.ws = ws; a.ph_lo = lo; a.ph_hi = hi;
        void* args[] = {&a};
        hipError_t e = hipLaunchCooperativeKernel((const void*)mk_fwd, dim3(grid_blocks), dim3(NWAVES * 64), args, LDS_BYTES, stream);
        if (e != hipSuccess) fprintf(stderr, "cooperative launch failed: %s (grid %d)\n", hipGetErrorString(e), grid_blocks);
    };
    if (hipMemsetAsync(ws + WS_CTL, 0, 32768, stream) != hipSuccess) { fprintf(stderr, "kernel_launch: memset failed\n"); return; }
    launch_mk(0, 9);
    (void)Z; (void)KIXN; (void)WIX; (void)SEL; (void)QL; (void)CN; (void)H; (void)CAT; (void)MIX; (void)Y;
    (void)x; (void)pre_norm; (void)w_in; (void)kv_norm; (void)w_uk; (void)w_uv; (void)kg; (void)kb; (void)w_pool; (void)pool_scale; (void)w_out; (void)post_norm;
}
```

```cpp
#include <hip/hip_runtime.h>
#include <stdint.h>
#include <cstdio>

typedef unsigned short bf16_t;
typedef short bf16x8 __attribute__((ext_vector_type(8)));
typedef float f32x4 __attribute__((ext_vector_type(4)));

constexpr int T = 8192, S = 2048, DM = 4096, DIN = 9808;
constexpr int ZP = 9984;
constexpr int ZQ = 0, ZC = 2048, ZQI = 2560, ZKIX = 3584, ZWIX = 3648, ZGA = 3840, ZPI = 5888, ZGB = 7936;
constexpr float EPS = 1e-6f;

constexpr size_t MiB = 1u << 20;
constexpr size_t WS_CTL = 0;
constexpr size_t WS_WUK = 1 * MiB, WS_WUV2 = 3 * MiB, WS_WPOOL = 7 * MiB;
constexpr size_t WS_WOUT = 10 * MiB;
constexpr size_t WS_CN = 42 * MiB, WS_KIXN = 50 * MiB, WS_WIX = 51 * MiB, WS_ROWSS = 51 * MiB + 512 * 1024, WS_SEL = 52 * MiB;
constexpr size_t WS_XN = 56 * MiB;
constexpr size_t WS_WIN = 120 * MiB;
constexpr size_t WS_Z = 198 * MiB;
constexpr size_t WS_QL = 354 * MiB;
constexpr size_t WS_END = 482 * MiB;
constexpr size_t WS_XN8 = WS_QL, WS_W8 = WS_QL + 32 * MiB;
constexpr int NT8 = 18, NTB = 21;
__device__ __forceinline__ bool zcol_is_f8(int col) { return col < 2560 || (col >= ZGA && col < ZGA + 2048); }
constexpr size_t WS_Y = WS_WIN, WS_MIX = WS_WIN, WS_RSS = WS_WIN + 64 * MiB;

__device__ __forceinline__ bf16_t f2bf(float f) { unsigned u = __float_as_uint(f); u += 0x7fffu + ((u >> 16) & 1u); return (bf16_t)(u >> 16); }
__device__ __forceinline__ float bf2f(bf16_t b) { return __uint_as_float(((unsigned)b) << 16); }
__device__ __forceinline__ unsigned pk2(float lo, float hi) { return (unsigned)f2bf(lo) | ((unsigned)f2bf(hi) << 16); }
__device__ __forceinline__ float bflo(unsigned u) { return __uint_as_float(u << 16); }
__device__ __forceinline__ float bfhi(unsigned u) { return __uint_as_float(u & 0xffff0000u); }
__device__ __forceinline__ float wave_sum(float v) {
#pragma unroll
    for (int o = 1; o < 64; o <<= 1) v += __shfl_xor(v, o);
    return v;
}
__device__ __forceinline__ float wave_max(float v) {
#pragma unroll
    for (int o = 1; o < 64; o <<= 1) v = fmaxf(v, __shfl_xor(v, o));
    return v;
}
__device__ __forceinline__ float silu(float x) { return x / (1.f + __expf(-x)); }

#include <hip/hip_cooperative_groups.h>
namespace cg = cooperative_groups;
#define LAS __attribute__((address_space(3)))
#define GAS __attribute__((address_space(1)))
typedef unsigned u32x4 __attribute__((ext_vector_type(4)));
typedef unsigned u32x2 __attribute__((ext_vector_type(2)));
constexpr int NWAVES = 8;
constexpr int LDS_BYTES = 147456;

__device__ __forceinline__ int lane_id() { int l; asm volatile("v_mbcnt_lo_u32_b32 %0, -1, 0\n\tv_mbcnt_hi_u32_b32 %0, -1, %0" : "=v"(l)); return l; }
namespace pg8 {
constexpr int BM = 256, BK = 64, HALF = 128, HTB = HALF * BK * 2, STAGE_BYTES = 8 * HTB, NXCD = 8, WGM = 8;
__device__ __forceinline__ int lds_byte(int r, int c) { const int st = (r >> 4) * 2 + (c >> 5), rr = r & 15, cc = c & 31, ob = rr * 64 + cc * 2; return st * 1024 + (ob ^ (((ob >> 9) & 1) << 5)); }
__device__ __forceinline__ void stage_rc(int b, int& R, int& C) { const int st = b / 1024, sb = b % 1024, swz = sb ^ (((sb >> 9) & 1) << 5); R = (st >> 1) * 16 + swz / 64; C = (st & 1) * 32 + (swz % 64) / 2; }
__device__ __forceinline__ int perm32(int rho) { const int n = rho >> 4, i = rho & 15; return 8 * (i >> 2) + 4 * n + (i & 3); }
struct Unit { int pm, pn; };
typedef int v4i_t __attribute__((ext_vector_type(4)));
typedef int v8i_t __attribute__((ext_vector_type(8)));
struct Gemm { const bf16_t* A; const bf16_t* Bt; int lda, ldb, K, a_shift, a_mul; int nt8; float rs8; };
struct StaticOrder {
    int nM, nN, nwg, G, c;
    int p0, rs, ra;
    int nfb, nl, kl;
    __device__ void init(int M, int N, int G_, int c_) { nM = M / BM; nN = N / BM; nwg = nM * nN; G = G_; c = c_; p0 = 0; rs = 1 << 30; ra = 0; nfb = -1; nl = 0; kl = 0; }
    __device__ bool next(int i, Unit& u) const {
        long L;
        if (nfb < 0) L = (long)i * G + c;
        else if (c >= nfb) { if (i >= kl) return false; L = (long)(c - nfb) + (long)nl * i; }
        else L = (long)kl * nl + c + (long)nfb * i;
        if (L >= nwg) return false;
        int wgid = (int)L; { const int q = nwg / NXCD, r = nwg % NXCD, xcd = wgid % NXCD, off = wgid / NXCD; wgid = (xcd < r ? xcd * (q + 1) : r * (q + 1) + (xcd - r) * q) + off; }
        const int nig = WGM * nN, gid = wgid / nig, fm = gid * WGM, gsz = (nM - fm) < WGM ? (nM - fm) : WGM;
        u.pm = fm + ((wgid % nig) % gsz); const int pn = (wgid % nig) / gsz; u.pn = p0 + pn + (pn >= rs ? ra : 0); return true;
    }
};
__device__ __forceinline__ unsigned cvt_pk_bf16(float lo, float hi) { unsigned r; asm volatile("v_cvt_pk_bf16_f32 %0, %1, %2" : "=v"(r) : "v"(lo), "v"(hi)); return r; }

struct EpiStore {
    static constexpr bool FINAL = false;
    bf16_t* O; int ldc; float sc;
    __device__ __forceinline__ void operator()(const f32x4 (&acc)[2][2][4][2], const Unit& u, int wr, int wc, int fr, int fq) const {
        const int row0 = u.pm * BM + wr * 64 + fr, col0 = u.pn * BM + wc * 32 + 8 * fq;
#pragma unroll
        for (int ai = 0; ai < 2; ++ai)
#pragma unroll
            for (int m = 0; m < 4; ++m) { bf16_t* rowp = O + (size_t)(row0 + ai * HALF + m * 16) * ldc + col0;
#pragma unroll
                for (int bj = 0; bj < 2; ++bj) { const f32x4 v0 = acc[ai][bj][m][0] * sc, v1 = acc[ai][bj][m][1] * sc;
                    u32x4 w; w.x = cvt_pk_bf16(v0[0], v0[1]); w.y = cvt_pk_bf16(v0[2], v0[3]); w.z = cvt_pk_bf16(v1[0], v1[1]); w.w = cvt_pk_bf16(v1[2], v1[3]);
                    *(u32x4*)(rowp + bj * HALF) = w; } }
    }
};

__device__ __forceinline__ float fsilu(float x) { return x * __builtin_amdgcn_rcpf(1.f + __expf(-x)); }
struct EpiGate {
    static constexpr bool FINAL = false;
    bf16_t* O; int ldc, ocol; const bf16_t* Zg; int gcol; const float* scale;
    __device__ __forceinline__ void operator()(const f32x4 (&acc)[2][2][4][2], const Unit& u, int wr, int wc, int fr, int fq) const {
        const int row0 = u.pm * BM + wr * 64 + fr, c0 = u.pn * BM + wc * 32 + 8 * fq;
#pragma unroll
        for (int ai = 0; ai < 2; ++ai)
#pragma unroll
            for (int m = 0; m < 4; ++m) { const size_t row = (size_t)(row0 + ai * HALF + m * 16);
#pragma unroll
                for (int bj = 0; bj < 2; ++bj) { const int c = c0 + bj * HALF;
                    const uint4 gz = *(const uint4*)(Zg + row * ZP + gcol + c);
                    f32x4 v0 = acc[ai][bj][m][0], v1 = acc[ai][bj][m][1];
                    if (scale) { v0 = v0 * *(const f32x4*)(scale + c); v1 = v1 * *(const f32x4*)(scale + c + 4); }
                    u32x4 w; w.x = cvt_pk_bf16(v0[0] * fsilu(bflo(gz.x)), v0[1] * fsilu(bfhi(gz.x))); w.y = cvt_pk_bf16(v0[2] * fsilu(bflo(gz.y)), v0[3] * fsilu(bfhi(gz.y)));
                    w.z = cvt_pk_bf16(v1[0] * fsilu(bflo(gz.z)), v1[1] * fsilu(bfhi(gz.z))); w.w = cvt_pk_bf16(v1[2] * fsilu(bflo(gz.w)), v1[3] * fsilu(bfhi(gz.w)));
                    *(u32x4*)(O + row * ldc + ocol + c) = w; } }
    }
};
struct EpiGate8 {
    static constexpr bool FINAL = false;
    unsigned char* O8; int pitch; const bf16_t* Zg; int gcol; float mul;
    __device__ __forceinline__ void operator()(const f32x4 (&acc)[2][2][4][2], const Unit& u, int wr, int wc, int fr, int fq) const {
        const int row0 = u.pm * BM + wr * 64 + fr, c0 = u.pn * BM + wc * 32 + 8 * fq;
#pragma unroll
        for (int ai = 0; ai < 2; ++ai)
#pragma unroll
            for (int m = 0; m < 4; ++m) { const size_t row = (size_t)(row0 + ai * HALF + m * 16);
#pragma unroll
                for (int bj = 0; bj < 2; ++bj) { const int c = c0 + bj * HALF;
                    const uint4 gz = *(const uint4*)(Zg + row * ZP + gcol + c);
                    const f32x4 v0 = acc[ai][bj][m][0] * mul, v1 = acc[ai][bj][m][1] * mul;
                    int lo = 0, hi = 0;
                    lo = __builtin_amdgcn_cvt_pk_fp8_f32(v0[0] * fsilu(bflo(gz.x)), v0[1] * fsilu(bfhi(gz.x)), lo, false); lo = __builtin_amdgcn_cvt_pk_fp8_f32(v0[2] * fsilu(bflo(gz.y)), v0[3] * fsilu(bfhi(gz.y)), lo, true);
                    hi = __builtin_amdgcn_cvt_pk_fp8_f32(v1[0] * fsilu(bflo(gz.z)), v1[1] * fsilu(bfhi(gz.z)), hi, false); hi = __builtin_amdgcn_cvt_pk_fp8_f32(v1[2] * fsilu(bflo(gz.w)), v1[3] * fsilu(bfhi(gz.w)), hi, true);
                    u32x2 w; w.x = (unsigned)lo; w.y = (unsigned)hi;
                    *(u32x2*)(O8 + row * (size_t)pitch + c) = w; } }
    }
};
struct EpiOut {
    static constexpr bool FINAL = false;
    bf16_t* Y; float* RSS;
    __device__ __forceinline__ void operator()(const f32x4 (&acc)[2][2][4][2], const Unit& u, int wr, int wc, int fr, int fq) const {
        const int row0 = u.pm * BM + wr * 64 + fr, col0 = u.pn * BM + wc * 32 + 8 * fq;
#pragma unroll
        for (int ai = 0; ai < 2; ++ai)
#pragma unroll
            for (int m = 0; m < 4; ++m) { const size_t row = (size_t)(row0 + ai * HALF + m * 16); float ss = 0.f;
#pragma unroll
                for (int bj = 0; bj < 2; ++bj) { const f32x4 v0 = acc[ai][bj][m][0], v1 = acc[ai][bj][m][1];
                    ss += (v0[0] * v0[0] + v0[1] * v0[1]) + (v0[2] * v0[2] + v0[3] * v0[3]) + (v1[0] * v1[0] + v1[1] * v1[1]) + (v1[2] * v1[2] + v1[3] * v1[3]);
                    u32x4 w; w.x = cvt_pk_bf16(v0[0], v0[1]); w.y = cvt_pk_bf16(v0[2], v0[3]); w.z = cvt_pk_bf16(v1[0], v1[1]); w.w = cvt_pk_bf16(v1[2], v1[3]);
                    *(u32x4*)(Y + row * DM + col0 + bj * HALF) = w; }
                ss += __shfl_xor(ss, 16); ss += __shfl_xor(ss, 32);
                if (fq == 0) RSS[row * 64 + u.pn * 4 + wc] = ss; }
    }
};

struct EpiStore8 {
    unsigned char* O; size_t pitch;
    __device__ __forceinline__ void operator()(const f32x4 (&acc)[2][2][4][2], const Unit& u, int wr, int wc, int fr, int fq) const {
        const int row0 = u.pm * BM + wr * 64 + fr, col0 = u.pn * BM + wc * 32 + 8 * fq;
#pragma unroll
        for (int ai = 0; ai < 2; ++ai)
#pragma unroll
            for (int m = 0; m < 4; ++m) { unsigned char* rowp = O + (size_t)(row0 + ai * HALF + m * 16) * pitch + col0;
#pragma unroll
                for (int bj = 0; bj < 2; ++bj) { const f32x4 v0 = acc[ai][bj][m][0], v1 = acc[ai][bj][m][1];
                    int lo = 0, hi = 0;
                    lo = __builtin_amdgcn_cvt_pk_fp8_f32(v0[0], v0[1], lo, false); lo = __builtin_amdgcn_cvt_pk_fp8_f32(v0[2], v0[3], lo, true);
                    hi = __builtin_amdgcn_cvt_pk_fp8_f32(v1[0], v1[1], hi, false); hi = __builtin_amdgcn_cvt_pk_fp8_f32(v1[2], v1[3], hi, true);
                    u32x2 w; w.x = (unsigned)lo; w.y = (unsigned)hi;
                    *(u32x2*)(rowp + bj * HALF) = w; } }
    }
};

template <class Epi, bool ALIGN_EPI, bool SP2, int MODE = 0>
__device__ __forceinline__ void gemm_phase(LAS unsigned char* lds, const int wave_id, const Gemm g, const StaticOrder& S, const Epi& E) {
    int lane = lane_id(); asm volatile("" : "+v"(lane));
    const int wid = wave_id, tid = wid * 64 + lane, wr = wid >> 2, wc = wid & 3, fr = lane & 15, fq = lane >> 4;
    const int K = g.K, nt = K / BK;
    unsigned voffA[2], voffB[2];
#pragma unroll
    for (int i = 0; i < 2; ++i) { int R, C; stage_rc(tid * 16 + i * 8192, R, C); const int Rb = (R & ~31) + perm32(R & 31);
        voffA[i] = (unsigned)(R * g.lda + C) * 2u; voffB[i] = (unsigned)(Rb * g.ldb + C) * 2u; }
    const size_t kstep = (size_t)(BK * 2);
    const size_t hstepA = (size_t)HALF * g.lda * 2, hstepB = (size_t)HALF * g.ldb * 2;
    const size_t tstepA = 2 * hstepA, tstepB = 2 * hstepB;
    const unsigned ldsw = (unsigned)wid * 1024u;
    const int aoff = lds_byte(wr * 64 + fr, fq * 8), boff = lds_byte(wc * 32 + fr, fq * 8);
#define PG8_SA(b, h) (((b) * 2 + (h)) * HTB)
#define PG8_SB(b, h) ((4 + (b) * 2 + (h)) * HTB)
#define PG8_STAGE(bufoff, gbase, voff) do { _Pragma("unroll") for (int _i = 0; _i < 2; ++_i) \
        __builtin_amdgcn_global_load_lds((const unsigned*)((const char*)(gbase) + (voff)[_i]), (LAS unsigned*)(lds + (bufoff) + ldsw + _i * 8192), 16, 0, 0); } while (0)
#define PG8_CAT(x, y) __builtin_shufflevector((x), (y), 0, 1, 2, 3, 4, 5, 6, 7)
#define PG8_LDA(dst, b, h, F8) do { _Pragma("unroll") for (int m = 0; m < 4; ++m) { \
        if constexpr (F8) dst##8[m] = PG8_CAT(*(const LAS v4i_t*)(lds + PG8_SA(b, h) + aoff + m * 2048), *(const LAS v4i_t*)(lds + PG8_SA(b, h) + aoff + m * 2048 + 1024)); \
        else { _Pragma("unroll") for (int k = 0; k < 2; ++k) dst[m][k] = *(const LAS bf16x8*)(lds + PG8_SA(b, h) + aoff + m * 2048 + k * 1024); } } } while (0)
#define PG8_LDB(dst, b, h, F8) do { _Pragma("unroll") for (int n = 0; n < 2; ++n) { \
        if constexpr (F8) dst##8[n] = PG8_CAT(*(const LAS v4i_t*)(lds + PG8_SB(b, h) + boff + n * 2048), *(const LAS v4i_t*)(lds + PG8_SB(b, h) + boff + n * 2048 + 1024)); \
        else { _Pragma("unroll") for (int k = 0; k < 2; ++k) dst[n][k] = *(const LAS bf16x8*)(lds + PG8_SB(b, h) + boff + n * 2048 + k * 1024); } } } while (0)
#define PG8_MMA(ai, bj, At, Bt, F8) do { __builtin_amdgcn_s_setprio(1); _Pragma("unroll") for (int m = 0; m < 4; ++m) _Pragma("unroll") for (int n = 0; n < 2; ++n) { \
        if constexpr (F8) asm volatile("v_mfma_f32_16x16x128_f8f6f4 %0, %1, %2, %0" : "+v"(acc[ai][bj][m][n]) : "v"(Bt##8[n]), "v"(At##8[m])); \
        else { _Pragma("unroll") for (int k = 0; k < 2; ++k) acc[ai][bj][m][n] = __builtin_amdgcn_mfma_f32_16x16x32_bf16(Bt[n][k], At[m][k], acc[ai][bj][m][n], 0, 0, 0); } } \
        __builtin_amdgcn_s_setprio(0); } while (0)
#define PG8_WAIT_V(n) asm volatile("s_waitcnt vmcnt(" #n ")" ::: "memory")
#define PG8_WAIT_L(n) asm volatile("s_waitcnt lgkmcnt(" #n ")" ::: "memory")
#define PG8_BAR __builtin_amdgcn_s_barrier()
#define PG8_SCHED __builtin_amdgcn_sched_barrier(0)
#define PG8_ABASE(u) ((const char*)g.A + (size_t)(u).pm * tstepA + (size_t)(((u).pn >> g.a_shift) * g.a_mul) * 2)
#define PG8_BBASE(u) ((const char*)g.Bt + (size_t)(u).pn * tstepB)
    Unit cur, nxt; int ui = 0;
    if (!S.next(0, cur)) return;
    f32x4 acc[2][2][4][2];
#pragma unroll
    for (int a = 0; a < 2; ++a)
#pragma unroll
        for (int b = 0; b < 2; ++b)
#pragma unroll
            for (int m = 0; m < 4; ++m)
#pragma unroll
                for (int n = 0; n < 2; ++n) acc[a][b][m][n] = (f32x4){0.f, 0.f, 0.f, 0.f};
    bf16x8 At[4][2], B0[2][2], B1[2][2]; v8i_t At8[4], B08[2], B18[2];
    const char* cA = PG8_ABASE(cur); const char* cB = PG8_BBASE(cur);
    if constexpr (SP2) {
        PG8_STAGE(PG8_SB(0, 0), cB, voffB); PG8_STAGE(PG8_SB(0, 1), cB + hstepB, voffB); PG8_STAGE(PG8_SA(0, 0), cA, voffA); PG8_STAGE(PG8_SA(0, 1), cA + hstepA, voffA);
        if (wr == 1) PG8_BAR;
        PG8_WAIT_V(2); PG8_BAR;
        PG8_STAGE(PG8_SB(1, 0), cB + kstep, voffB); PG8_STAGE(PG8_SA(1, 0), cA + kstep, voffA); PG8_STAGE(PG8_SB(1, 1), cB + hstepB + kstep, voffB);
        PG8_WAIT_V(6); PG8_BAR;
    } else {
        PG8_STAGE(PG8_SB(0, 0), cB, voffB); PG8_STAGE(PG8_SA(0, 0), cA, voffA); PG8_STAGE(PG8_SB(0, 1), cB + hstepB, voffB); PG8_STAGE(PG8_SA(0, 1), cA + hstepA, voffA);
        if (wr == 1) PG8_BAR;
        PG8_WAIT_V(4); PG8_BAR;
        PG8_STAGE(PG8_SB(1, 0), cB + kstep, voffB); PG8_STAGE(PG8_SA(1, 0), cA + kstep, voffA); PG8_STAGE(PG8_SB(1, 1), cB + hstepB + kstep, voffB);
        PG8_WAIT_V(6); PG8_BAR;
    }
    for (;;) {
        const bool has_next = S.next(ui + 1, nxt);
        const char* nA = has_next ? PG8_ABASE(nxt) : cA; const char* nB = has_next ? PG8_BBASE(nxt) : cB;
#define PG8_KPTRS() const bool last = (t == nt - 2); const char* a1 = cA + (size_t)(t + 1) * kstep; \
            const char* a2 = last ? nA : cA + (size_t)(t + 2) * kstep; const char* b2 = last ? nB : cB + (size_t)(t + 2) * kstep; const char* a3 = a2 + kstep; const char* b3 = b2 + kstep
#define PG8_KBODY(F8) \
            PG8_LDB(B0, 0, 0, F8); PG8_LDB(B1, 0, 1, F8); PG8_SCHED; PG8_LDA(At, 0, 0, F8); PG8_STAGE(PG8_SA(1, 1), a1 + hstepA, voffA); \
            PG8_WAIT_V(8); PG8_WAIT_L(0); PG8_BAR; PG8_MMA(0, 0, At, B0, F8); PG8_MMA(0, 1, At, B1, F8); PG8_BAR; PG8_SCHED; \
            PG8_LDA(At, 0, 1, F8); PG8_STAGE(PG8_SB(0, 0), b2, voffB); PG8_STAGE(PG8_SB(0, 1), b2 + hstepB, voffB); PG8_STAGE(PG8_SA(0, 0), a2, voffA); \
            PG8_WAIT_V(8); PG8_WAIT_L(0); PG8_BAR; PG8_MMA(1, 0, At, B0, F8); PG8_MMA(1, 1, At, B1, F8); PG8_BAR; PG8_SCHED; \
            PG8_LDB(B0, 1, 0, F8); PG8_LDB(B1, 1, 1, F8); PG8_SCHED; PG8_LDA(At, 1, 0, F8); PG8_STAGE(PG8_SA(0, 1), a2 + hstepA, voffA); \
            PG8_WAIT_V(8); PG8_WAIT_L(0); PG8_BAR; PG8_MMA(0, 0, At, B0, F8); PG8_MMA(0, 1, At, B1, F8); PG8_BAR; PG8_SCHED; \
            PG8_LDA(At, 1, 1, F8); PG8_STAGE(PG8_SB(1, 0), b3, voffB); PG8_STAGE(PG8_SB(1, 1), b3 + hstepB, voffB); PG8_STAGE(PG8_SA(1, 0), a3, voffA); \
            PG8_WAIT_V(8); PG8_WAIT_L(0); PG8_BAR; PG8_MMA(1, 0, At, B0, F8); PG8_MMA(1, 1, At, B1, F8); PG8_BAR; PG8_SCHED
        int t = 0;
        if constexpr (MODE != 0) {
            const int nt8 = (MODE == 1) ? nt : g.nt8;
            for (; t < nt8; t += 2) { PG8_KPTRS(); PG8_KBODY(true); }
            if constexpr (MODE == 2) {
                asm volatile("s_nop 15\n\ts_nop 15" ::: "memory");
                const float rs8 = g.rs8;
#pragma unroll
                for (int a = 0; a < 2; ++a)
#pragma unroll
                    for (int b = 0; b < 2; ++b)
#pragma unroll
                        for (int m = 0; m < 4; ++m)
#pragma unroll
                            for (int n = 0; n < 2; ++n) acc[a][b][m][n] = acc[a][b][m][n] * rs8;
            }
        }
        if constexpr (MODE != 1) {
            for (; t < nt; t += 2) { PG8_KPTRS(); PG8_KBODY(false); }
        }
        if constexpr (ALIGN_EPI) { if (wr == 0) PG8_BAR; }
        if constexpr (MODE == 1) asm volatile("s_nop 15\n\ts_nop 15" ::: "memory");
        if constexpr (Epi::FINAL) { if (!has_next) E.final(acc, cur, wr, wc, fr, fq); else E(acc, cur, wr, wc, fr, fq); }
        else E(acc, cur, wr, wc, fr, fq);
        if (!has_next) break;
#pragma unroll
        for (int a = 0; a < 2; ++a)
#pragma unroll
            for (int b = 0; b < 2; ++b)
#pragma unroll
                for (int m = 0; m < 4; ++m)
#pragma unroll
                    for (int n = 0; n < 2; ++n) acc[a][b][m][n] = (f32x4){0.f, 0.f, 0.f, 0.f};
        cur = nxt; cA = nA; cB = nB; ++ui;
        if constexpr (ALIGN_EPI) { if (wr == 1) PG8_BAR; }
    }
    PG8_WAIT_V(0);
    if constexpr (!ALIGN_EPI) { if (wr == 0) PG8_BAR; }
    PG8_BAR;
#undef PG8_SA
#undef PG8_SB
#undef PG8_STAGE
#undef PG8_LDA
#undef PG8_LDB
#undef PG8_MMA
#undef PG8_KPTRS
#undef PG8_KBODY
#undef PG8_CAT
#undef PG8_WAIT_V
#undef PG8_WAIT_L
#undef PG8_BAR
#undef PG8_SCHED
#undef PG8_ABASE
#undef PG8_BBASE
}
}

__device__ __forceinline__ void relu_fmac(float& acc, float w, float d) { const float t = fmaxf(d, 0.f); asm("v_fmac_f32 %0, %1, %2" : "+v"(acc) : "v"(w), "v"(t)); }
__device__ __forceinline__ int count_ge8(unsigned u0, unsigned u1, unsigned u2, unsigned u3, unsigned u4, unsigned u5, unsigned u6, unsigned u7, unsigned c) {
    unsigned long long m0, m1, m2, m3, m4, m5, m6, m7;
    asm("v_cmp_ge_u32_e64 %0, %8, %16\n\tv_cmp_ge_u32_e64 %1, %9, %16\n\tv_cmp_ge_u32_e64 %2, %10, %16\n\tv_cmp_ge_u32_e64 %3, %11, %16\n\t"
        "v_cmp_ge_u32_e64 %4, %12, %16\n\tv_cmp_ge_u32_e64 %5, %13, %16\n\tv_cmp_ge_u32_e64 %6, %14, %16\n\tv_cmp_ge_u32_e64 %7, %15, %16"
        : "=&s"(m0), "=&s"(m1), "=&s"(m2), "=&s"(m3), "=&s"(m4), "=&s"(m5), "=&s"(m6), "=&s"(m7)
        : "v"(u0), "v"(u1), "v"(u2), "v"(u3), "v"(u4), "v"(u5), "v"(u6), "v"(u7), "v"(c));
    return (__builtin_popcountll(m0) + __builtin_popcountll(m1)) + (__builtin_popcountll(m2) + __builtin_popcountll(m3)) + ((__builtin_popcountll(m4) + __builtin_popcountll(m5)) + (__builtin_popcountll(m6) + __builtin_popcountll(m7)));
}
__device__ __forceinline__ void acc_ge8(int& cnt, unsigned u0, unsigned u1, unsigned u2, unsigned u3, unsigned u4, unsigned u5, unsigned u6, unsigned u7, unsigned c) {
    asm("v_cmp_ge_u32_e32 vcc, %1, %9\n\tv_addc_co_u32_e32 %0, vcc, 0, %0, vcc\n\tv_cmp_ge_u32_e32 vcc, %2, %9\n\tv_addc_co_u32_e32 %0, vcc, 0, %0, vcc\n\t"
        "v_cmp_ge_u32_e32 vcc, %3, %9\n\tv_addc_co_u32_e32 %0, vcc, 0, %0, vcc\n\tv_cmp_ge_u32_e32 vcc, %4, %9\n\tv_addc_co_u32_e32 %0, vcc, 0, %0, vcc\n\t"
        "v_cmp_ge_u32_e32 vcc, %5, %9\n\tv_addc_co_u32_e32 %0, vcc, 0, %0, vcc\n\tv_cmp_ge_u32_e32 vcc, %6, %9\n\tv_addc_co_u32_e32 %0, vcc, 0, %0, vcc\n\t"
        "v_cmp_ge_u32_e32 vcc, %7, %9\n\tv_addc_co_u32_e32 %0, vcc, 0, %0, vcc\n\tv_cmp_ge_u32_e32 vcc, %8, %9\n\tv_addc_co_u32_e32 %0, vcc, 0, %0, vcc"
        : "+v"(cnt) : "v"(u0), "v"(u1), "v"(u2), "v"(u3), "v"(u4), "v"(u5), "v"(u6), "v"(u7), "v"(c) : "vcc");
}
__device__ __forceinline__ int wave_total(int x) {
    x += __builtin_amdgcn_update_dpp(0, x, 0x111, 0xf, 0xf, true);
    x += __builtin_amdgcn_update_dpp(0, x, 0x112, 0xf, 0xf, true);
    x += __builtin_amdgcn_update_dpp(0, x, 0x114, 0xf, 0xf, true);
    x += __builtin_amdgcn_update_dpp(0, x, 0x118, 0xf, 0xf, true);
    x += __builtin_amdgcn_update_dpp(0, x, 0x142, 0xa, 0xf, false);
    x += __builtin_amdgcn_update_dpp(0, x, 0x143, 0xc, 0xf, false);
    return __builtin_amdgcn_readlane(x, 63);
}
#define LDS_WAIT() asm volatile("s_waitcnt lgkmcnt(0)" ::: "memory")
struct P0Tile { const float* src; int ld; bf16_t* dst; int dld; };
__device__ __forceinline__ void p0_tile_load(const P0Tile& t, int lane, f32x4 (&v)[16]) {
#pragma unroll
    for (int i = 0; i < 16; ++i) v[i] = t.src ? __builtin_nontemporal_load((const f32x4*)(t.src + (size_t)((lane >> 4) + 4 * i) * t.ld + (lane & 15) * 4)) : (f32x4){0.f, 0.f, 0.f, 0.f};
}
__device__ __forceinline__ void p0_tile_store(const P0Tile& t, int lane, const f32x4 (&v)[16], LAS float* scr) {
#pragma unroll
    for (int i = 0; i < 16; ++i) { LAS float* p = scr + ((lane >> 4) + 4 * i) * 65 + (lane & 15) * 4; p[0] = v[i][0]; p[1] = v[i][1]; p[2] = v[i][2]; p[3] = v[i][3]; }
    LDS_WAIT(); asm volatile("" ::: "memory");
    const int c = lane >> 3, nl = lane & 7;
    if (t.dld < 0) {
#pragma unroll
        for (int j = 0; j < 8; ++j) { const LAS float* s = scr + (8 * c) * 65 + nl + 8 * j; int lo = 0, hi = 0;
            lo = __builtin_amdgcn_cvt_pk_fp8_f32(64.f * s[0 * 65], 64.f * s[1 * 65], lo, false); lo = __builtin_amdgcn_cvt_pk_fp8_f32(64.f * s[2 * 65], 64.f * s[3 * 65], lo, true);
            hi = __builtin_amdgcn_cvt_pk_fp8_f32(64.f * s[4 * 65], 64.f * s[5 * 65], hi, false); hi = __builtin_amdgcn_cvt_pk_fp8_f32(64.f * s[6 * 65], 64.f * s[7 * 65], hi, true);
            u32x2 o; o.x = (unsigned)lo; o.y = (unsigned)hi;
            *(u32x2*)((unsigned char*)t.dst + (size_t)(nl + 8 * j) * (size_t)(-t.dld) + 8 * c) = o; }
    } else
#pragma unroll
    for (int j = 0; j < 8; ++j) { const LAS float* s = scr + (8 * c) * 65 + nl + 8 * j;
        u32x4 o; o.x = pg8::cvt_pk_bf16(s[0 * 65], s[1 * 65]); o.y = pg8::cvt_pk_bf16(s[2 * 65], s[3 * 65]); o.z = pg8::cvt_pk_bf16(s[4 * 65], s[5 * 65]); o.w = pg8::cvt_pk_bf16(s[6 * 65], s[7 * 65]);
        *(u32x4*)(t.dst + (size_t)(nl + 8 * j) * t.dld + 8 * c) = o; }
    LDS_WAIT(); asm volatile("" ::: "memory");
}

#define XB_TMO      128
#define XB_XCNT(j)  (256  + 64 * (j))
#define XB_XSUB(j)  (1280 + 64 * (j))
#define XB_XGEN(j)  (2304 + 64 * (j))
#define XB_TOP      3328
#define XB_TOPGEN   3392
#define XCD_BAR_WORDS 3456
#define XB_SPIN_CAP (1u << 22)
__device__ __forceinline__ unsigned xb_ld(unsigned* p)              { return __hip_atomic_load(p, __ATOMIC_RELAXED, __HIP_MEMORY_SCOPE_AGENT); }
__device__ __forceinline__ unsigned xb_add(unsigned* p, unsigned v) { return __hip_atomic_fetch_add(p, v, __ATOMIC_RELAXED, __HIP_MEMORY_SCOPE_AGENT); }
__device__ __forceinline__ unsigned xb_xcc_id() { return (unsigned)__builtin_amdgcn_s_getreg((3 << 11) | 20) & 0xFu; }
#define XB_SPIN(cond, bar) do { unsigned _sp = 0; while (cond) { __builtin_amdgcn_s_sleep(1); \
    if ((++_sp & 255u) == 0u) { if (xb_ld(&(bar)[XB_TMO])) break; if (_sp > XB_SPIN_CAP) { atomicAdd(&(bar)[XB_TMO], 1u); break; } } } } while (0)
__device__ __forceinline__ void xcd_barrier_complete(unsigned* bar, unsigned x, unsigned G, unsigned& nloc, unsigned& nx) {
    unsigned sum, cnt, mine, sp = 0u;
    for (;;) {
        sum = 0u; cnt = 0u; mine = 0u;
#pragma unroll
        for (unsigned j = 0; j < 16; ++j) { const unsigned c = xb_ld(&bar[XB_XCNT(j)]); sum += c; cnt += (c > 0u) ? 1u : 0u; mine = (j == x) ? c : mine; }
        if (sum == G) break;
        __builtin_amdgcn_s_sleep(1);
        if ((++sp & 255u) == 0u) { if (xb_ld(&bar[XB_TMO])) break; if (sp > XB_SPIN_CAP) { atomicAdd(&bar[XB_TMO], 1u); break; } }
    }
    nloc = mine > 0u ? mine : 1u; nx = cnt > 0u ? cnt : 1u;
}
__device__ __forceinline__ void xcd_barrier(unsigned* bar, unsigned x, unsigned G, volatile LAS unsigned* st, bool is_leader) {
    asm volatile("s_waitcnt vmcnt(0)" ::: "memory");
    __syncthreads();
    if (is_leader) {
        __builtin_amdgcn_s_waitcnt(0);
        unsigned nloc = st[0], nx = st[1];
        if (nloc == 0u) { xcd_barrier_complete(bar, x, G, nloc, nx); st[0] = nloc; st[1] = nx; }
        const unsigned old = xb_add(&bar[XB_XSUB(x)], 1u);
        const unsigned gen = old / nloc;
        if (old + 1u == (gen + 1u) * nloc) {
            __builtin_amdgcn_fence(__ATOMIC_RELEASE, "agent");
            asm volatile("s_waitcnt vmcnt(0)" ::: "memory");
            const unsigned og = xb_add(&bar[XB_TOP], 1u);
            const unsigned tg = og / nx;
            if (og + 1u == (tg + 1u) * nx) xb_add(&bar[XB_TOPGEN], 1u);
            else XB_SPIN(xb_ld(&bar[XB_TOPGEN]) == tg, bar);
            __builtin_amdgcn_fence(__ATOMIC_ACQUIRE, "agent");
            xb_add(&bar[XB_XGEN(x)], 1u);
            asm volatile("s_waitcnt vmcnt(0)" ::: "memory");
        } else {
            XB_SPIN(xb_ld(&bar[XB_XGEN(x)]) == gen, bar);
            __builtin_amdgcn_fence(__ATOMIC_ACQUIRE, "agent");
            asm volatile("s_waitcnt vmcnt(0)" ::: "memory");
        }
    }
    __syncthreads();
}

struct EpiOutF {
    static constexpr bool FINAL = true;
    bf16_t* Y; float* RSS; const float* x; const float* pw; float* out; unsigned* bar; unsigned xcc, G; volatile LAS unsigned* st;
    __device__ __forceinline__ void operator()(const f32x4 (&acc)[2][2][4][2], const pg8::Unit& u, int wr, int wc, int fr, int fq) const { pg8::EpiOut E{Y, RSS}; E(acc, u, wr, wc, fr, fq); }
    __device__ __forceinline__ void final(const f32x4 (&acc)[2][2][4][2], const pg8::Unit& u, int wr, int wc, int fr, int fq) const {
        const int row0 = u.pm * pg8::BM + wr * 64 + fr, col0 = u.pn * pg8::BM + wc * 32 + 8 * fq;
#pragma unroll
        for (int ai = 0; ai < 2; ++ai)
#pragma unroll
            for (int m = 0; m < 4; ++m) { const size_t row = (size_t)(row0 + ai * pg8::HALF + m * 16); float ss = 0.f;
#pragma unroll
                for (int bj = 0; bj < 2; ++bj) { const f32x4 v0 = acc[ai][bj][m][0], v1 = acc[ai][bj][m][1];
                    ss += (v0[0] * v0[0] + v0[1] * v0[1]) + (v0[2] * v0[2] + v0[3] * v0[3]) + (v1[0] * v1[0] + v1[1] * v1[1]) + (v1[2] * v1[2] + v1[3] * v1[3]); }
                ss += __shfl_xor(ss, 16); ss += __shfl_xor(ss, 32);
                if (fq == 0) RSS[row * 64 + u.pn * 4 + wc] = ss; }
        xcd_barrier(bar, xcc, G, st, wr == 0 && wc == 0 && fr == 0 && fq == 0);
        f32x4 w0[2], w1[2];
#pragma unroll
        for (int bj = 0; bj < 2; ++bj) { w0[bj] = *(const f32x4*)(pw + col0 + bj * pg8::HALF); w1[bj] = *(const f32x4*)(pw + col0 + bj * pg8::HALF + 4); }
#pragma unroll
        for (int ai = 0; ai < 2; ++ai)
#pragma unroll
            for (int m = 0; m < 4; ++m) { const size_t row = (size_t)(row0 + ai * pg8::HALF + m * 16);
                const f32x4* rp = (const f32x4*)(RSS + row * 64 + 16 * fq);
                const f32x4 r0 = rp[0], r1 = rp[1], r2 = rp[2], r3 = rp[3];
                float ss = ((r0[0] + r0[1]) + (r0[2] + r0[3])) + ((r1[0] + r1[1]) + (r1[2] + r1[3])) + (((r2[0] + r2[1]) + (r2[2] + r2[3])) + ((r3[0] + r3[1]) + (r3[2] + r3[3])));
                ss += __shfl_xor(ss, 16); ss += __shfl_xor(ss, 32);
                const float rs = rsqrtf(ss * (1.f / DM) + EPS);
#pragma unroll
                for (int bj = 0; bj < 2; ++bj) { const size_t o = row * DM + col0 + bj * pg8::HALF;
                    const f32x4 x0 = __builtin_nontemporal_load((const f32x4*)(x + o)), x1 = __builtin_nontemporal_load((const f32x4*)(x + o + 4));
                    *(f32x4*)(out + o) = x0 + acc[ai][bj][m][0] * rs * w0[bj]; *(f32x4*)(out + o + 4) = x1 + acc[ai][bj][m][1] * rs * w1[bj]; } }
    }
};

#ifndef PROBE_DUP
#define PROBE_DUP 0
#endif
#define DUPN(k) (1 + (((PROBE_DUP) >> (k)) & 1))
struct MkArgs { const float* in[12]; float* out; unsigned char* ws; int ph_lo, ph_hi; };

__global__ void __launch_bounds__(NWAVES * 64, 2) mk_fwd(MkArgs a) {
    extern __shared__ __attribute__((aligned(1024))) unsigned char lds_raw[];
    cg::grid_group grid = cg::this_grid();
    LAS unsigned char* lds = (LAS unsigned char*)lds_raw;
    const int G = gridDim.x, bx = blockIdx.x;
    const int vcu = (G % 8 == 0) ? (bx % 8) * (G / 8) + bx / 8 : bx;
    const int NGW = G * NWAVES;
    const int wave0 = __builtin_amdgcn_readfirstlane((int)threadIdx.x >> 6);
#define PHASE_IDS() int lane = lane_id(); asm volatile("" : "+v"(lane)); const int wave = wave0, tid = wave * 64 + lane, gw = vcu * NWAVES + wave; (void)tid; (void)gw
    unsigned char* ws = a.ws;
    const float* x = a.in[0]; const float* pre_norm = a.in[1]; const float* w_in = a.in[2]; const float* kv_norm = a.in[3];
    const float* w_uk = a.in[4]; const float* w_uv = a.in[5]; const float* kg = a.in[6]; const float* kb = a.in[7];
    const float* w_pool = a.in[8]; const float* pool_scale = a.in[9]; const float* w_out = a.in[10]; const float* post_norm = a.in[11];
    bf16_t* XN = (bf16_t*)(ws + WS_XN); bf16_t* CAT = (bf16_t*)(ws + WS_XN); bf16_t* WIN = (bf16_t*)(ws + WS_WIN); bf16_t* Z = (bf16_t*)(ws + WS_Z);
    bf16_t* WOUT = (bf16_t*)(ws + WS_WOUT); bf16_t* WUK = (bf16_t*)(ws + WS_WUK); bf16_t* WUV2 = (bf16_t*)(ws + WS_WUV2); bf16_t* WPOOL = (bf16_t*)(ws + WS_WPOOL);
    bf16_t* CN = (bf16_t*)(ws + WS_CN); bf16_t* KIXN = (bf16_t*)(ws + WS_KIXN); float* WIX = (float*)(ws + WS_WIX);
    bf16_t* MIX = (bf16_t*)(ws + WS_MIX); bf16_t* Y = (bf16_t*)(ws + WS_Y); float* RSS = (float*)(ws + WS_RSS); bf16_t* QL = (bf16_t*)(ws + WS_QL);
    const int lo = a.ph_lo, hi = a.ph_hi;
#define IN(k) (lo <= (k) && (k) < hi)
    unsigned* const xbar = (unsigned*)(ws + WS_CTL) + 1024;
    volatile LAS unsigned* const xst = (volatile LAS unsigned*)(lds + 147456 - 64);
    if (a.ph_lo < 0) grid.sync();
    const unsigned xcc = xb_xcc_id();
    { const int _l = lane_id();
      if (wave0 == 0 && _l == 0) { xst[0] = 0u; xst[1] = 0u; (void)xb_add(&xbar[XB_XCNT(xcc)], 1u); } }
#define SEAM(k) do { if (IN(k) && IN((k) + 1)) { const int _l = lane_id(); xcd_barrier(xbar, xcc, (unsigned)G, xst, wave0 == 0 && _l == 0); } } while (0)

    constexpr int NB_IN = ZP / 64, I_IN = (DM / 64) * NB_IN;
    constexpr int I_OUT = (DM / 64) * (DM / 64);
    constexpr int I_POOL = 4 * 8 * 8;
    constexpr int I_UV = 16 * 8 * 2 * 2;
    constexpr int I_T = I_IN + I_OUT + I_POOL + I_UV;
    auto tile_of = [&](int it, int lane) -> P0Tile {
        P0Tile t;
        if (it < I_IN) { const int kb_ = it / NB_IN, nb = it % NB_IN; const int np = nb * 64 + (lane & 15) * 4;
            const int scol = np < 3664 ? np : (np >= 3840 ? np - 176 : -1);
            t.src = scol >= 0 ? w_in + (size_t)(kb_ * 64) * DIN + scol - (lane & 15) * 4 : nullptr; t.ld = DIN; t.dst = WIN + (size_t)(nb * 64) * DM + kb_ * 64; t.dld = DM;
            if (zcol_is_f8(nb * 64)) { t.dst = (bf16_t*)(ws + WS_W8 + (size_t)(nb * 64) * DM + kb_ * 64); t.dld = -DM; }
            return t; }
        it -= I_IN;
        if (it < I_OUT) { const int kb_ = it >> 6, nb = it & 63; t.src = w_out + (size_t)(kb_ * 64) * DM + nb * 64; t.ld = DM;
            if (kb_ < 32) { t.dst = (bf16_t*)(ws + WS_WOUT + (size_t)(nb * 64) * 6144 + kb_ * 64); t.dld = -6144; }
            else { t.dst = WOUT + (size_t)(nb * 64) * 3072 + 1024 + (kb_ - 32) * 64; t.dld = 3072; }
            return t; }
        it -= I_OUT;
        if (it < I_POOL) { const int g_ = it >> 6, kb_ = (it >> 3) & 7, nb = it & 7; t.src = w_pool + (size_t)g_ * 512 * 512 + (size_t)(kb_ * 64) * 512 + nb * 64; t.ld = 512;
            t.dst = WPOOL + (size_t)(g_ * 512 + nb * 64) * 512 + kb_ * 64; t.dld = 512; return t; }
        it -= I_POOL;
        { const int z = it & 1, r = it >> 1, h = r >> 4, kb_ = (r >> 1) & 7, nb = r & 1;
          t.src = z ? nullptr : w_uv + (size_t)h * 512 * 128 + (size_t)(kb_ * 64) * 128 + nb * 64; t.ld = 128;
          t.dst = (bf16_t*)((unsigned char*)WUV2 + (size_t)(h * 128 + nb * 64) * 1024 + ((h & 1) ^ z) * 512 + kb_ * 64); t.dld = -1024; return t; }
    };
#define P0_RUN_TILES(FIRST, LAST, GWI, NGWI) do { \
        f32x4 va[16], vb[16]; \
        int it = (FIRST) + (GWI); \
        if (it < (LAST)) { P0Tile ta = tile_of(it, lane); p0_tile_load(ta, lane, va); \
            for (;;) { \
                const int itb = it + (NGWI); P0Tile tb = ta; const bool hb = itb < (LAST); \
                if (hb) { tb = tile_of(itb, lane); p0_tile_load(tb, lane, vb); } \
                p0_tile_store(ta, lane, va, scr); \
                if (!hb) break; \
                const int ita = itb + (NGWI); const bool ha = ita < (LAST); \
                if (ha) { ta = tile_of(ita, lane); p0_tile_load(ta, lane, va); } \
                p0_tile_store(tb, lane, vb, scr); \
                if (!ha) break; \
                it = ita; \
            } \
        } } while (0)
    if (IN(0)) for (int rep_ = 0; rep_ < DUPN(0); ++rep_) {
        PHASE_IDS();
        LAS float* scr = (LAS float*)(lds + wave * 17408);
        P0_RUN_TILES(0, I_IN, gw, NGW);
        for (int row = gw; row < T; row += NGW) {
            const float4* xr = (const float4*)(x + (size_t)row * DM);
            float4 v[16]; float ss = 0.f;
#pragma unroll
            for (int j = 0; j < 16; ++j) { const f32x4 t_ = __builtin_nontemporal_load((const f32x4*)xr + lane + 64 * j); v[j] = make_float4(t_[0], t_[1], t_[2], t_[3]); ss += v[j].x * v[j].x + v[j].y * v[j].y + v[j].z * v[j].z + v[j].w * v[j].w; }
            ss = wave_sum(ss);
            const float rs = rsqrtf(ss * (1.f / DM) + EPS);
            uint2* o = (uint2*)(XN + (size_t)row * DM); unsigned* o8 = (unsigned*)(ws + WS_XN8 + (size_t)row * DM);
#pragma unroll
            for (int j = 0; j < 16; ++j) { const float4 gg = ((const float4*)pre_norm)[lane + 64 * j];
                const float n0 = v[j].x * rs * gg.x, n1 = v[j].y * rs * gg.y, n2 = v[j].z * rs * gg.z, n3 = v[j].w * rs * gg.w;
                uint2 w; w.x = pk2(n0, n1); w.y = pk2(n2, n3); o[lane + 64 * j] = w;
                int q8 = 0; q8 = __builtin_amdgcn_cvt_pk_fp8_f32(n0, n1, q8, false); q8 = __builtin_amdgcn_cvt_pk_fp8_f32(n2, n3, q8, true); o8[lane + 64 * j] = (unsigned)q8; }
        }
    }
    SEAM(0);
    if (IN(1)) for (int rep_ = 0; rep_ < DUPN(1); ++rep_) {
        constexpr int NUB = (T / 256) * NTB, NU8 = (T / 256) * NT8;
        { pg8::Gemm g{XN, WIN, DM, DM, DM, 0, 0}; pg8::StaticOrder So; So.init(T, NTB * 256, G, bx); So.p0 = 10; So.rs = 5; So.ra = 8;
          pg8::EpiStore E{Z, ZP, 1.f};
          pg8::gemm_phase<pg8::EpiStore, true, true>(lds, wave0, g, So, E); }
        { pg8::Gemm g{(const bf16_t*)(ws + WS_XN8), (const bf16_t*)(ws + WS_W8), DM / 2, DM / 2, DM / 2, 0, 0}; pg8::StaticOrder So; So.init(T, NT8 * 256, G, bx); So.p0 = 0; So.rs = 10; So.ra = 5;
          if (G == 256) { So.nfb = NUB - 2 * 256; So.nl = 256 - So.nfb; So.kl = 4; }
          pg8::EpiStore E{Z, ZP, 1.f / 64.f};
          pg8::gemm_phase<pg8::EpiStore, true, true, 1>(lds, wave0, g, So, E); }
    }
    if (IN(1)) {
        PHASE_IDS();
        constexpr int NUB = (T / 256) * NTB, NU8 = (T / 256) * NT8;
        int nhelp = G, hidx = bx;
        if (G == 256) { constexpr int nfb = NUB - 2 * 256, h0 = NU8 - 4 * (256 - nfb) - nfb; static_assert(nfb == 160 && h0 == 32, "unit hand-out"); nhelp = nfb - h0; hidx = (bx >= h0 && bx < nfb) ? bx - h0 : -1; }
        if (hidx >= 0) {
            LAS float* scr = (LAS float*)(lds + wave * 17408);
            const int gwi = hidx * NWAVES + wave, ngwi = nhelp * NWAVES;
            P0_RUN_TILES(I_IN, I_T, gwi, ngwi);
            for (int it = gwi; it < 2048; it += ngwi) {
                const float4* p = (const float4*)(w_uk + (size_t)it * 512 + lane * 8); const float4 v0 = p[0], v1 = p[1];
                uint4 o; o.x = pk2(v0.x, v0.y); o.y = pk2(v0.z, v0.w); o.z = pk2(v1.x, v1.y); o.w = pk2(v1.z, v1.w); *(uint4*)(WUK + (size_t)it * 512 + lane * 8) = o; }
        }
    }
    SEAM(1);
    if (IN(2)) for (int rep_ = 0; rep_ < DUPN(2); ++rep_) {
        PHASE_IDS();
        for (int row = gw; row < T; row += NGW) {
            const bf16_t* zr = Z + (size_t)row * ZP;
            { const uint4 u = *(const uint4*)(zr + ZC + lane * 8);
              const float c0 = bflo(u.x), c1 = bfhi(u.x), c2 = bflo(u.y), c3 = bfhi(u.y), c4 = bflo(u.z), c5 = bfhi(u.z), c6 = bflo(u.w), c7 = bfhi(u.w);
              float ss = (c0 * c0 + c1 * c1) + (c2 * c2 + c3 * c3) + (c4 * c4 + c5 * c5) + (c6 * c6 + c7 * c7);
              ss = wave_sum(ss); const float rs = rsqrtf(ss * (1.f / 512.f) + EPS);
              const float4 g0 = ((const float4*)kv_norm)[lane * 2], g1 = ((const float4*)kv_norm)[lane * 2 + 1];
              int lo = 0, hi = 0;
              lo = __builtin_amdgcn_cvt_pk_fp8_f32(c0 * rs * g0.x, c1 * rs * g0.y, lo, false); lo = __builtin_amdgcn_cvt_pk_fp8_f32(c2 * rs * g0.z, c3 * rs * g0.w, lo, true);
              hi = __builtin_amdgcn_cvt_pk_fp8_f32(c4 * rs * g1.x, c5 * rs * g1.y, hi, false); hi = __builtin_amdgcn_cvt_pk_fp8_f32(c6 * rs * g1.z, c7 * rs * g1.w, hi, true);
              uint2 o; o.x = (unsigned)lo; o.y = (unsigned)hi;
              *(uint2*)((unsigned char*)CN + (size_t)row * 512 + lane * 8) = o; }
            { const float v = bf2f(zr[ZKIX + lane]); const float mu = wave_sum(v) * (1.f / 64.f); const float d = v - mu; const float var = wave_sum(d * d) * (1.f / 64.f);
              KIXN[(size_t)row * 64 + lane] = f2bf(d * rsqrtf(var + EPS) * kg[lane] + kb[lane]); }
            if (lane < 16) WIX[(size_t)row * 16 + lane] = bf2f(zr[ZWIX + lane]) * 0.25f;
        }
        for (int run = vcu * 2 + (tid >> 8); run < T / 16; run += 2 * G) {
            const int cs = tid & 255, t0 = run * 16, pos0 = t0 & (S - 1), g_ = cs >> 6, w = 2 << g_;
            const bf16_t* zc = Z + ZPI + cs * 8;
            float s0 = 0.f, s1 = 0.f, s2 = 0.f, s3 = 0.f, s4 = 0.f, s5 = 0.f, s6 = 0.f, s7 = 0.f;
            const int nh = (w - 1) < pos0 ? (w - 1) : pos0;
            for (int hh = 1; hh <= nh; ++hh) { const uint4 u = *(const uint4*)(zc + (size_t)(t0 - hh) * ZP);
                s0 += bflo(u.x); s1 += bfhi(u.x); s2 += bflo(u.y); s3 += bfhi(u.y); s4 += bflo(u.z); s5 += bfhi(u.z); s6 += bflo(u.w); s7 += bfhi(u.w); }
#pragma unroll 4
            for (int i = 0; i < 16; ++i) {
                const int t = t0 + i, pos = pos0 + i;
                const uint4 u = *(const uint4*)(zc + (size_t)t * ZP);
                const bool drop = i > 0 && pos >= w;
                uint4 od = make_uint4(0u, 0u, 0u, 0u); if (drop) od = *(const uint4*)(zc + (size_t)(t - w) * ZP);
                s0 += bflo(u.x) - bflo(od.x); s1 += bfhi(u.x) - bfhi(od.x); s2 += bflo(u.y) - bflo(od.y); s3 += bfhi(u.y) - bfhi(od.y);
                s4 += bflo(u.z) - bflo(od.z); s5 += bfhi(u.z) - bfhi(od.z); s6 += bflo(u.w) - bflo(od.w); s7 += bfhi(u.w) - bfhi(od.w);
                const int cnt = (pos + 1) < w ? (pos + 1) : w; const float inv = 1.f / (float)cnt;
                uint4 o; o.x = pk2(s0 * inv - bflo(u.x), s1 * inv - bfhi(u.x)); o.y = pk2(s2 * inv - bflo(u.y), s3 * inv - bfhi(u.y));
                o.z = pk2(s4 * inv - bflo(u.z), s5 * inv - bfhi(u.z)); o.w = pk2(s6 * inv - bflo(u.w), s7 * inv - bfhi(u.w));
                *(uint4*)(MIX + (size_t)t * 2048 + cs * 8) = o;
            }
        }
    }
    SEAM(2);
    if (DUPN(9) > 1) for (int e_ = 0; e_ < 8; ++e_) { const int _l = lane_id(); xcd_barrier(xbar, xcc, (unsigned)G, xst, wave0 == 0 && _l == 0); }
    if (IN(3)) for (int rep_ = 0; rep_ < DUPN(3); ++rep_) {
        {
            PHASE_IDS();
            const int g = lane >> 4, hl = lane & 15;
            for (int tk = vcu; tk < 256; tk += G) {
                const int h = tk & 15, rr = tk >> 4;
                __syncthreads();
#pragma unroll 4
                for (int i = 0; i < 16; ++i) { const int r0 = (wave * 16 + i) * 4, r = r0 + (lane >> 4), sw = (((r >> 4) & 3) << 2) | (r & 3);
                    const unsigned char* srcp = (const unsigned char*)WUK + (size_t)(h * 512 + r) * 256 + (((lane & 15) ^ sw) << 4);
                    __builtin_amdgcn_global_load_lds((const unsigned*)srcp, (LAS unsigned*)(lds + r0 * 256), 16, 0, 0); }
                asm volatile("s_waitcnt vmcnt(0)" ::: "memory"); __syncthreads();
                const unsigned abase = (unsigned)(size_t)lds + (unsigned)((16 * (hl >> 2) + (hl & 3)) * 256 + ((g ^ hl) << 4));
                bf16x8 qB[4];
                { const bf16_t* qp = Z + (size_t)(rr * 512 + wave * 16 + hl) * ZP + ZQ + h * 128 + g * 8;
#pragma unroll
                  for (int ks = 0; ks < 4; ++ks) qB[ks] = *(const bf16x8*)(qp + ks * 32); }
                for (int rg = wave; rg < 32; rg += NWAVES) {
                    const int t0 = rr * 512 + rg * 16, rgn = rg + NWAVES < 32 ? rg + NWAVES : rg;
                    bf16x8 qN[4];
                    { const bf16_t* qp = Z + (size_t)(rr * 512 + rgn * 16 + hl) * ZP + ZQ + h * 128 + g * 8;
#pragma unroll
                      for (int ks = 0; ks < 4; ++ks) qN[ks] = *(const bf16x8*)(qp + ks * 32); }
                    unsigned char* orow = (unsigned char*)QL + (size_t)(t0 + hl) * 16384 + h * 512 + 16 * g;
#pragma unroll 2
                    for (int cb = 0; cb < 8; ++cb) {
                        f32x4 acc[4];
#pragma unroll
                        for (int j = 0; j < 4; ++j) { acc[j] = (f32x4){0.f, 0.f, 0.f, 0.f};
#pragma unroll
                            for (int ks = 0; ks < 4; ++ks) {
                                const unsigned ad = (abase & ~0xF0u) + cb * 16384 + j * 1024 + ((((unsigned)(ks * 4 + g)) ^ (unsigned)hl) << 4);
                                const bf16x8 a = *(const LAS bf16x8*)(size_t)ad;
                                acc[j] = __builtin_amdgcn_mfma_f32_16x16x32_bf16(a, qB[ks], acc[j], 0, 0, 0); } }
                        u32x4 w;
                        { int d0 = 0, d1 = 0, d2 = 0, d3 = 0;
                          d0 = __builtin_amdgcn_cvt_pk_fp8_f32(acc[0][0], acc[0][1], d0, false); d0 = __builtin_amdgcn_cvt_pk_fp8_f32(acc[0][2], acc[0][3], d0, true);
                          d1 = __builtin_amdgcn_cvt_pk_fp8_f32(acc[1][0], acc[1][1], d1, false); d1 = __builtin_amdgcn_cvt_pk_fp8_f32(acc[1][2], acc[1][3], d1, true);
                          d2 = __builtin_amdgcn_cvt_pk_fp8_f32(acc[2][0], acc[2][1], d2, false); d2 = __builtin_amdgcn_cvt_pk_fp8_f32(acc[2][2], acc[2][3], d2, true);
                          d3 = __builtin_amdgcn_cvt_pk_fp8_f32(acc[3][0], acc[3][1], d3, false); d3 = __builtin_amdgcn_cvt_pk_fp8_f32(acc[3][2], acc[3][3], d3, true);
                          w.x = (unsigned)d0; w.y = (unsigned)d1; w.z = (unsigned)d2; w.w = (unsigned)d3; }
                        *(u32x4*)(orow + cb * 64) = w;
                    }
#pragma unroll
                    for (int ks = 0; ks < 4; ++ks) qB[ks] = qN[ks];
                }
            }
            __syncthreads();
        }
        { pg8::Gemm g{MIX, WPOOL, 2048, 512, 512, 1, 512}; pg8::StaticOrder So; So.init(T, 2048, G, bx);
          pg8::EpiGate E{CAT, 3072, 1024, Z, ZGB, pool_scale};
          for (int r2_ = 0; r2_ < DUPN(11); ++r2_) pg8::gemm_phase<pg8::EpiGate, true, true>(lds, wave0, g, So, E); }
    }
    if (IN(3)) for (int rep_ = 0; rep_ < DUPN(4); ++rep_) {
        PHASE_IDS();
        constexpr int SCP = 2052;
        LAS float* sc = (LAS float*)lds;
        unsigned short* SEL = (unsigned short*)(ws + WS_SEL);
        for (int k0 = vcu; k0 < 256; k0 += G)
        for (int side = 0; side < 2; ++side) {
            const int uu = side == 0 ? k0 : 511 - k0;
            const int j = uu >> 4, r_ = uu & 15, b = r_ >> 2, q4 = r_ & 3;
            const int t0 = b * S + j * 64 + q4 * 16, N = (j + 1) * 64;
            int lo_ = lane; asm volatile("" : "+v"(lo_));
            const int g = lo_ >> 4, hl = lo_ & 15;
            if (N <= 256) {
#pragma unroll
                for (int qq = 0; qq < 2; ++qq) { unsigned short* so = SEL + (size_t)(t0 + wave * 2 + qq) * 256;
#pragma unroll
                    for (int k = 0; k < 4; ++k) so[lo_ + 64 * k] = (unsigned short)(lo_ + 64 * k); }
                continue;
            }
            for (int r12_ = 0; r12_ < DUPN(12); ++r12_)
            {
                bf16x8 qb[16][2];
                const bf16_t* qrow = Z + (size_t)(t0 + hl) * ZP + ZQI + g * 8;
#pragma unroll
                for (int h = 0; h < 16; ++h) { qb[h][0] = *(const bf16x8*)(qrow + h * 64); qb[h][1] = *(const bf16x8*)(qrow + h * 64 + 32); }
                float wq[16];
                { const float4* wp = (const float4*)(WIX + (size_t)(t0 + hl) * 16);
#pragma unroll
                  for (int k = 0; k < 4; ++k) { const float4 w4 = wp[k]; wq[4 * k] = w4.x * 0.125f; wq[4 * k + 1] = w4.y * 0.125f; wq[4 * k + 2] = w4.z * 0.125f; wq[4 * k + 3] = w4.w * 0.125f; } }
                bf16x8 qsh[2], qsl[2];
#pragma unroll
                for (int ks = 0; ks < 2; ++ks) { float qs[8];
#pragma unroll
                    for (int e = 0; e < 8; ++e) qs[e] = 0.f;
#pragma unroll
                    for (int h = 0; h < 16; ++h)
#pragma unroll
                        for (int e = 0; e < 8; ++e) qs[e] += wq[h] * bf2f((bf16_t)qb[h][ks][e]);
#pragma unroll
                    for (int e = 0; e < 8; ++e) { const bf16_t hi = f2bf(qs[e]); qsh[ks][e] = (short)hi; qsl[ks][e] = (short)f2bf(qs[e] - bf2f(hi)); } }
                const int ntile = N >> 4;
                int kt = wave;
                const bf16_t* krow = KIXN + (size_t)(b * S + hl) * 64 + g * 8;
                bf16x8 a0 = *(const bf16x8*)(krow + (size_t)kt * 1024), a1 = *(const bf16x8*)(krow + (size_t)kt * 1024 + 32);
                for (; kt < ntile; kt += NWAVES) {
                    const int kn = (kt + NWAVES < ntile) ? kt + NWAVES : kt;
                    const bf16x8 n0 = *(const bf16x8*)(krow + (size_t)kn * 1024), n1 = *(const bf16x8*)(krow + (size_t)kn * 1024 + 32);
                    f32x4 dl = __builtin_amdgcn_mfma_f32_16x16x32_bf16(a0, qsh[0], (f32x4){0.f, 0.f, 0.f, 0.f}, 0, 0, 0);
                    dl = __builtin_amdgcn_mfma_f32_16x16x32_bf16(a1, qsh[1], dl, 0, 0, 0);
                    dl = __builtin_amdgcn_mfma_f32_16x16x32_bf16(a0, qsl[0], dl, 0, 0, 0);
                    dl = __builtin_amdgcn_mfma_f32_16x16x32_bf16(a1, qsl[1], dl, 0, 0, 0);
                    float c0_ = 0.f, c1_ = 0.f, c2_ = 0.f, c3_ = 0.f;
#pragma unroll
                    for (int h = 0; h < 16; ++h) {
                        f32x4 d = __builtin_amdgcn_mfma_f32_16x16x32_bf16(a0, qb[h][0], (f32x4){0.f, 0.f, 0.f, 0.f}, 0, 0, 0);
                        d = __builtin_amdgcn_mfma_f32_16x16x32_bf16(a1, qb[h][1], d, 0, 0, 0);
                        c0_ = __builtin_fmaf(__builtin_fabsf(d[0]), wq[h], c0_); asm("" : "+v"(c0_));
                        c1_ = __builtin_fmaf(__builtin_fabsf(d[1]), wq[h], c1_); asm("" : "+v"(c1_));
                        c2_ = __builtin_fmaf(__builtin_fabsf(d[2]), wq[h], c2_); asm("" : "+v"(c2_));
                        c3_ = __builtin_fmaf(__builtin_fabsf(d[3]), wq[h], c3_); asm("" : "+v"(c3_));
                    }
                    *(LAS f32x4*)(sc + hl * SCP + kt * 16 + 4 * g) = (f32x4){0.5f * (dl[0] + c0_), 0.5f * (dl[1] + c1_), 0.5f * (dl[2] + c2_), 0.5f * (dl[3] + c3_)};
                    a0 = n0; a1 = n1;
                }
            }
            __syncthreads();
            const int ni = N >> 6;
            for (int r13_ = 0; r13_ < DUPN(13); ++r13_)
            {
                int lq = lane; asm volatile("" : "+v"(lq));
                const int qa = wave * 2;
                unsigned ua[32], ub[32];
#pragma unroll
                for (int i = 0; i < 32; ++i) { ua[i] = 0u; ub[i] = 0u;
                    if (i < ni) { const unsigned ba = __float_as_uint(sc[qa * SCP + i * 64 + lq]), bb = __float_as_uint(sc[(qa + 1) * SCP + i * 64 + lq]);
                        ua[i] = ba ^ ((ba >> 31) ? 0xFFFFFFFFu : 0x80000000u); ub[i] = bb ^ ((bb >> 31) ? 0xFFFFFFFFu : 0x80000000u); } }
                unsigned Ta = 0u, Tb = 0u; bool da = false, db = false;
                for (int bit = 31; bit >= 0; --bit) {
                    const unsigned ca = Ta | (1u << bit), cb = Tb | (1u << bit); int la = 0, lb = 0;
#pragma unroll
                    for (int i8 = 0; i8 < 4; ++i8) if (i8 * 8 < ni) {
                        acc_ge8(la, ua[i8 * 8], ua[i8 * 8 + 1], ua[i8 * 8 + 2], ua[i8 * 8 + 3], ua[i8 * 8 + 4], ua[i8 * 8 + 5], ua[i8 * 8 + 6], ua[i8 * 8 + 7], ca);
                        acc_ge8(lb, ub[i8 * 8], ub[i8 * 8 + 1], ub[i8 * 8 + 2], ub[i8 * 8 + 3], ub[i8 * 8 + 4], ub[i8 * 8 + 5], ub[i8 * 8 + 6], ub[i8 * 8 + 7], cb); }
                    const int na = wave_total(la), nb = wave_total(lb);
                    if (!da) { if (na >= 256) Ta = ca; da = (na == 256); }
                    if (!db) { if (nb >= 256) Tb = cb; db = (nb == 256); }
                    if (da && db) break;
                }
#pragma unroll
                for (int qq = 0; qq < 2; ++qq) {
                    const unsigned Tt = qq ? Tb : Ta;
                    unsigned short* so = SEL + (size_t)(t0 + qa + qq) * 256;
                    const unsigned long long lt = (1ull << lq) - 1ull;
                    int base = 0;
#pragma unroll
                    for (int i = 0; i < 32; ++i) if (i < ni) { const unsigned uv = qq ? ub[i] : ua[i]; const bool pr = uv > Tt; const unsigned long long mk = __ballot(pr);
                        if (pr) so[base + __builtin_popcountll(mk & lt)] = (unsigned short)(i * 64 + lq); base += __builtin_popcountll(mk); }
#pragma unroll
                    for (int i = 0; i < 32; ++i) if (i < ni) { const unsigned uv = qq ? ub[i] : ua[i]; const bool pr = uv == Tt; const unsigned long long mk = __ballot(pr);
                        const int ps = base + __builtin_popcountll(mk & lt); if (pr && ps < 256) so[ps] = (unsigned short)(i * 64 + lq); base += __builtin_popcountll(mk); }
                }
            }
            __syncthreads();
        }
    }
    if (IN(3) && IN(5)) { const int _l = lane_id(); xcd_barrier(xbar, xcc, (unsigned)G, xst, wave0 == 0 && _l == 0); }
    if (IN(5)) for (int rep_ = 0; rep_ < DUPN(5); ++rep_) {
        PHASE_IDS();
        const int g = lane >> 4, hl = lane & 15;
        const unsigned short* SEL = (const unsigned short*)(ws + WS_SEL);
        LAS unsigned char* reg = lds + wave * 16384;
#define FSW8(s) ((((s) & 15) ^ (((s) & 16) >> 1)))
        const unsigned regb = (unsigned)(size_t)reg;
        unsigned xb0;
        { const int f0 = FSW8(hl);
          xb0 = regb + (unsigned)(hl * 512 + (((2 * g) ^ f0) << 4)); }
        unsigned yb;
        { const int q = hl >> 1, p = hl & 1, rq = q < 4 ? 4 * g + q : 16 + 4 * g + (q - 4), f = FSW8(rq); yb = regb + (unsigned)(rq * 512 + (f << 4) + 8 * p); }
        unsigned lhalf = (unsigned)(lane >> 5), lbase = (((unsigned)(lane & 31)) ^ lhalf) << 4;
        const float SCL = 0.08838834764831845f * 1.4426950408889634f;
        for (int wq = gw; wq < 2048; wq += NGW) {
            const int b = wq >> 9, widx = wq & 511;
            const unsigned char* cbase = (const unsigned char*)CN + (size_t)b * S * 512;
            typedef int v8i __attribute__((ext_vector_type(8)));
            v8i qf[4];
            { const unsigned char* qrow = (const unsigned char*)QL + (size_t)(b * S + widx) * 16384 + hl * 512 + g * 32;
#pragma unroll
              for (int kk = 0; kk < 4; ++kk) qf[kk] = *(const v8i*)(qrow + kk * 128); }
            for (int i4 = 0; i4 < 4; ++i4) {
                const int pos = i4 * 512 + widx, t = b * S + pos;
                const int N = ((pos >> 6) + 1) * 64, nv = N < 256 ? N : 256, nw = nv >> 6;
                f32x4 O[32];
#pragma unroll
                for (int n = 0; n < 32; ++n) O[n] = (f32x4){0.f, 0.f, 0.f, 0.f};
                float m = -1e30f, lsum = 0.f;
#define P5_KEYS(KV, KQ) do { _Pragma("unroll") for (int d2 = 0; d2 < 8; ++d2) { \
                    const unsigned pA = (unsigned)__builtin_amdgcn_readlane((KV), (KQ) * 32 + 4 * d2) | ((unsigned)__builtin_amdgcn_readlane((KV), (KQ) * 32 + 4 * d2 + 2) << 16); \
                    const unsigned pB = (unsigned)__builtin_amdgcn_readlane((KV), (KQ) * 32 + 4 * d2 + 1) | ((unsigned)__builtin_amdgcn_readlane((KV), (KQ) * 32 + 4 * d2 + 3) << 16); \
                    kp[d2] = lhalf ? pB : pA; } } while (0)
                unsigned kp[8];
                int kcur = (int)SEL[(size_t)t * 256 + lane];
                P5_KEYS(kcur, 0);
                for (int w = 0; w < nw; ++w) {
                    const int knext = (w + 1 < nw) ? (int)SEL[(size_t)t * 256 + (w + 1) * 64 + lane] : kcur;
                    for (int kq = 0; kq < 2; ++kq) {
                        asm volatile("s_waitcnt lgkmcnt(0)" : "+v"(lbase), "+v"(lhalf), "+v"(xb0), "+v"(yb) :: "memory");
#pragma unroll
                        for (int d = 0; d < 16; ++d) { const unsigned key = (d & 1) ? (kp[d >> 1] >> 16) : (kp[d >> 1] & 0xffffu);
                            __builtin_amdgcn_global_load_lds((const unsigned*)(cbase + (size_t)((lbase ^ (unsigned)(((((2 * d) & 15) ^ (d >= 8 ? 8 : 0))) << 4)) + (key << 9))), (LAS unsigned*)(reg + d * 1024), 16, 0, 0); }
                        asm volatile("s_waitcnt vmcnt(8)" ::: "memory");
                        f32x4 sT0 = (f32x4){0.f, 0.f, 0.f, 0.f}, sT1 = (f32x4){0.f, 0.f, 0.f, 0.f};
#pragma unroll
                        for (int kk = 0; kk < 4; ++kk) {
                            const unsigned ad = (xb0 ^ (unsigned)((kk & 1) << 7)) + (kk >> 1) * 256;
                            const u32x4 lo = *(const LAS u32x4*)(size_t)ad, hi = *(const LAS u32x4*)(size_t)(ad ^ 16u);
                            const v8i a0 = (v8i){(int)lo.x, (int)lo.y, (int)lo.z, (int)lo.w, (int)hi.x, (int)hi.y, (int)hi.z, (int)hi.w};
                            sT0 = __builtin_amdgcn_mfma_scale_f32_16x16x128_f8f6f4(a0, qf[kk], sT0, 0, 0, 0, 0, 0, 0);
                        }
                        asm volatile("s_waitcnt vmcnt(0)" ::: "memory");
#pragma unroll
                        for (int kk = 0; kk < 4; ++kk) {
                            const unsigned ad = (xb0 ^ (unsigned)(((kk & 1) << 7) ^ 128)) + 8192 + (kk >> 1) * 256;
                            const u32x4 lo = *(const LAS u32x4*)(size_t)ad, hi = *(const LAS u32x4*)(size_t)(ad ^ 16u);
                            const v8i a1 = (v8i){(int)lo.x, (int)lo.y, (int)lo.z, (int)lo.w, (int)hi.x, (int)hi.y, (int)hi.z, (int)hi.w};
                            sT1 = __builtin_amdgcn_mfma_scale_f32_16x16x128_f8f6f4(a1, qf[kk], sT1, 0, 0, 0, 0, 0, 0);
                        }
                        if (w == nw - 1 && kq == 1 && i4 < 3) {
                            const unsigned char* qrow = (const unsigned char*)QL + (size_t)(t + 512) * 16384 + hl * 512 + g * 32;
#pragma unroll
                            for (int kk = 0; kk < 4; ++kk) qf[kk] = *(const v8i*)(qrow + kk * 128); }
                        const float s0 = sT0[0] * SCL, s1 = sT0[1] * SCL, s2 = sT0[2] * SCL, s3 = sT0[3] * SCL, s4 = sT1[0] * SCL, s5 = sT1[1] * SCL, s6 = sT1[2] * SCL, s7 = sT1[3] * SCL;
                        float mx = fmaxf(fmaxf(fmaxf(s0, s1), fmaxf(s2, s3)), fmaxf(fmaxf(s4, s5), fmaxf(s6, s7)));
                        { const unsigned mu = __float_as_uint(mx); const auto r16 = __builtin_amdgcn_permlane16_swap(mu, mu, false, false);
                          mx = fmaxf(__uint_as_float(r16[0]), __uint_as_float(r16[1]));
                          const unsigned mv = __float_as_uint(mx); const auto r32 = __builtin_amdgcn_permlane32_swap(mv, mv, false, false);
                          mx = fmaxf(__uint_as_float(r32[0]), __uint_as_float(r32[1])); }
                        if (!__all(mx - m <= 6.f)) {
                            const float mn = fmaxf(m, mx), alpha = __builtin_amdgcn_exp2f(m - mn); m = mn; lsum *= alpha;
#pragma unroll
                            for (int n = 0; n < 32; ++n) O[n] = O[n] * alpha;
                        }
                        const float p0 = __builtin_amdgcn_exp2f(s0 - m), p1 = __builtin_amdgcn_exp2f(s1 - m), p2 = __builtin_amdgcn_exp2f(s2 - m), p3 = __builtin_amdgcn_exp2f(s3 - m), p4 = __builtin_amdgcn_exp2f(s4 - m), p5 = __builtin_amdgcn_exp2f(s5 - m), p6 = __builtin_amdgcn_exp2f(s6 - m), p7 = __builtin_amdgcn_exp2f(s7 - m);
                        lsum += ((p0 + p1) + (p2 + p3)) + ((p4 + p5) + (p6 + p7));
                        int plo = 0, phi = 0;
                        plo = __builtin_amdgcn_cvt_pk_fp8_f32(p0, p1, plo, false); plo = __builtin_amdgcn_cvt_pk_fp8_f32(p2, p3, plo, true);
                        phi = __builtin_amdgcn_cvt_pk_fp8_f32(p4, p5, phi, false); phi = __builtin_amdgcn_cvt_pk_fp8_f32(p6, p7, phi, true);
                        const long pf = ((long)phi << 32) | (unsigned)plo;
                        if (kq == 0) P5_KEYS(kcur, 1); else P5_KEYS(knext, 0);
#pragma unroll
                        for (int n = 0; n < 32; ++n) {
                            typedef int v2i __attribute__((ext_vector_type(2)));
                            const v2i tr = __builtin_amdgcn_ds_read_tr8_b64_v2i32((LAS v2i*)((size_t)(yb ^ (unsigned)((n & 15) << 4)) + (n >> 4) * 256));
                            const long ct = ((long)tr[1] << 32) | (unsigned)tr[0];
                            O[n] = __builtin_amdgcn_mfma_f32_16x16x32_fp8_fp8(ct, pf, O[n], 0, 0, 0);
                        }
                    }
                    kcur = knext;
                }
#undef P5_KEYS
                float lt = lsum + __shfl_xor(lsum, 16); lt += __shfl_xor(lt, 32);
                const float inv = 16.f / lt;
                unsigned wbase = (unsigned)(hl * 512 + (hl << 4) + 4 * g);
                unsigned lx = (unsigned)((lane >> 5) * 512 + (((lane & 31) ^ (lane >> 5)) << 4));
                asm volatile("s_waitcnt lgkmcnt(0)" : "+v"(wbase), "+v"(lx) :: "memory");
#pragma unroll
                for (int n = 0; n < 32; ++n) { const f32x4 o = O[n] * inv; int w = 0;
                    w = __builtin_amdgcn_cvt_pk_fp8_f32(o[0], o[1], w, false); w = __builtin_amdgcn_cvt_pk_fp8_f32(o[2], o[3], w, true);
                    *(LAS unsigned*)(reg + (wbase ^ (unsigned)(n << 4))) = (unsigned)w; }
                asm volatile("s_waitcnt lgkmcnt(0)" ::: "memory");
                { unsigned char* orow = (rep_ > 0 ? ws + WS_WIN + (size_t)gw * 16384 : (unsigned char*)QL + (size_t)t * 16384) + lane * 16;
#pragma unroll
                  for (int h2 = 0; h2 < 8; ++h2) { const u32x4 v = *(const LAS u32x4*)(reg + h2 * 1024 + (lx ^ (unsigned)(h2 << 5))); *(u32x4*)(orow + h2 * 1024) = v; } }
            }
        }
#undef FSW8
    }
    SEAM(5);
    if (IN(6)) for (int rep_ = 0; rep_ < DUPN(6); ++rep_) {
        pg8::Gemm g{QL, WUV2, 8192, 512, 512, 0, 512}; pg8::StaticOrder So; So.init(T, 2048, G, bx);
        pg8::EpiGate8 E{(unsigned char*)CAT, 6144, Z, ZGA, 1.f / 64.f};
        pg8::gemm_phase<pg8::EpiGate8, true, true, 1>(lds, wave0, g, So, E);
    }
    SEAM(6);
    const bool fuse8 = (G == 256) && IN(7) && IN(8) && DUPN(7) == 1;
    if (IN(7)) for (int rep_ = 0; rep_ < DUPN(7); ++rep_) {
        pg8::Gemm g{CAT, WOUT, 3072, 3072, 3072, 0, 0, 16, 1.f / 1024.f}; pg8::StaticOrder So; So.init(T, DM, G, bx);
        if (fuse8) { const int _l = lane_id();
            EpiOutF E{Y, RSS, x, post_norm, a.out, xbar, xcc, (unsigned)G, xst};
            pg8::gemm_phase<EpiOutF, true, true, 2>(lds, wave0, g, So, E); (void)_l; }
        else { pg8::EpiOut E{Y, RSS};
            pg8::gemm_phase<pg8::EpiOut, true, true, 2>(lds, wave0, g, So, E); }
    }
    if (!fuse8) SEAM(7);
    if (IN(8)) for (int rep_ = 0; rep_ < DUPN(8); ++rep_) {
        PHASE_IDS();
        for (int row = gw; row < T; row += NGW) {
            const float ss = wave_sum(RSS[(size_t)row * 64 + lane]);
            const float rs = rsqrtf(ss * (1.f / DM) + EPS);
            const uint4* yr = (const uint4*)(Y + (size_t)row * DM);
#pragma unroll
            for (int j = 0; j < 8; ++j) { if (fuse8 && (j & 2)) continue;
                const u32x4 u_ = __builtin_nontemporal_load((const u32x4*)yr + lane + 64 * j); const uint4 u = make_uint4(u_.x, u_.y, u_.z, u_.w); const size_t c = (size_t)(lane + 64 * j) * 8;
                const float4* xp = (const float4*)(x + (size_t)row * DM + c); const float4* gp = (const float4*)(post_norm + c);
                const f32x4 xa_ = __builtin_nontemporal_load((const f32x4*)xp), xb_ = __builtin_nontemporal_load((const f32x4*)xp + 1);
                const float4 x0 = make_float4(xa_[0], xa_[1], xa_[2], xa_[3]), x1 = make_float4(xb_[0], xb_[1], xb_[2], xb_[3]), g0 = gp[0], g1 = gp[1]; float4 o0, o1;
                o0.x = x0.x + bflo(u.x) * rs * g0.x; o0.y = x0.y + bfhi(u.x) * rs * g0.y; o0.z = x0.z + bflo(u.y) * rs * g0.z; o0.w = x0.w + bfhi(u.y) * rs * g0.w;
                o1.x = x1.x + bflo(u.z) * rs * g1.x; o1.y = x1.y + bfhi(u.z) * rs * g1.y; o1.z = x1.z + bflo(u.w) * rs * g1.z; o1.w = x1.w + bfhi(u.w) * rs * g1.w;
                float4* op = (float4*)(a.out + (size_t)row * DM + c); op[0] = o0; op[1] = o1; }
        }
    }
#undef IN
#undef SEAM
}

extern "C" void kernel_launch(void* const* d_in, const int* in_sizes, int n_in, void* d_out, int out_size, void* d_ws, size_t ws_size, hipStream_t stream) {
    if (n_in != 12 || in_sizes[0] != T * DM || out_size != T * DM || ws_size < WS_END) { fprintf(stderr, "kernel_launch: unexpected shapes/ws (%d %d %d %zu)\n", n_in, n_in > 0 ? in_sizes[0] : -1, out_size, ws_size); return; }
    const float* x = (const float*)d_in[0]; const float* pre_norm = (const float*)d_in[1]; const float* w_in = (const float*)d_in[2]; const float* kv_norm = (const float*)d_in[3];
    const float* w_uk = (const float*)d_in[4]; const float* w_uv = (const float*)d_in[5]; const float* kg = (const float*)d_in[6]; const float* kb = (const float*)d_in[7];
    const float* w_pool = (const float*)d_in[8]; const float* pool_scale = (const float*)d_in[9]; const float* w_out = (const float*)d_in[10]; const float* post_norm = (const float*)d_in[11];
    unsigned char* ws = (unsigned char*)d_ws; float* out = (float*)d_out;
    bf16_t* H = (bf16_t*)(ws + WS_XN); bf16_t* CAT = (bf16_t*)(ws + WS_XN); bf16_t* Z = (bf16_t*)(ws + WS_Z); bf16_t* CN = (bf16_t*)(ws + WS_CN); bf16_t* KIXN = (bf16_t*)(ws + WS_KIXN);
    float* WIX = (float*)(ws + WS_WIX); unsigned short* SEL = (unsigned short*)(ws + WS_SEL); bf16_t* MIX = (bf16_t*)(ws + WS_WIN); bf16_t* Y = (bf16_t*)(ws + WS_WIN); bf16_t* QL = (bf16_t*)(ws + WS_QL);

    static int grid_blocks = 0;
    if (grid_blocks == 0) {
        int dev = 0, cus = 0, per_cu = 0;
        if (hipGetDevice(&dev) != hipSuccess || hipDeviceGetAttribute(&cus, hipDeviceAttributeMultiprocessorCount, dev) != hipSuccess) { fprintf(stderr, "kernel_launch: device query failed\n"); grid_blocks = -1; return; }
        if (hipFuncSetAttribute((const void*)mk_fwd, hipFuncAttributeMaxDynamicSharedMemorySize, LDS_BYTES) != hipSuccess) { fprintf(stderr, "kernel_launch: hipFuncSetAttribute failed\n"); grid_blocks = -1; return; }
        if (hipOccupancyMaxActiveBlocksPerMultiprocessor(&per_cu, (const void*)mk_fwd, NWAVES * 64, LDS_BYTES) != hipSuccess || per_cu < 1) { fprintf(stderr, "kernel_launch: occupancy query failed (%d)\n", per_cu); grid_blocks = -1; return; }
        grid_blocks = cus * per_cu;
        fprintf(stderr, "kernel_launch: %d CUs x %d blocks/CU = grid %d\n", cus, per_cu, grid_blocks);
    }
    if (grid_blocks < 0) return;
    auto launch_mk = [&](int lo, int hi) {
        MkArgs a{}; for (int i = 0; i < 12; ++i) a.in[i] = (const float*)d_in[i]; a.out = out; a.ws = ws; a.ph_lo = lo; a.ph_hi = hi;
        void* args[] = {&a};
        hipError_t e = hipLaunchCooperativeKernel((const void*)mk_fwd, dim3(grid_blocks), dim3(NWAVES * 64), args, LDS_BYTES, stream);
        if (e != hipSuccess) fprintf(stderr, "cooperative launch failed: %s (grid %d)\n", hipGetErrorString(e), grid_blocks);
    };
    if (hipMemsetAsync(ws + WS_CTL, 0, 32768, stream) != hipSuccess) { fprintf(stderr, "kernel_launch: memset failed\n"); return; }
    launch_mk(0, 9);
    (void)Z; (void)KIXN; (void)WIX; (void)SEL; (void)QL; (void)CN; (void)H; (void)CAT; (void)MIX; (void)Y;
    (void)x; (void)pre_norm; (void)w_in; (void)kv_norm; (void)w_uk; (void)w_uv; (void)kg; (void)kb; (void)w_pool; (void)pool_scale; (void)w_out; (void)post_norm;
}
```
